# Optimizing an MI355X kernel written in HIP

```python
import math
import jax, jax.numpy as jnp
from jax import lax
import numpy as np

D_MODEL = 1024
BATCH = 16
SEQ = 256
DEPTH = 2
DEC_BATCH = 4
DEC_SEQ = 2048
PAST_LEN = 256

GRID_W = 64
MIX_WIDTH = D_MODEL
HALF = MIX_WIDTH // 2
POOL_WINDOWS = (2, 4, 8, 16)
POOL_GROUP = HALF // len(POOL_WINDOWS)
CONV_WIDTH = 3
HEAD_DIM = 64
N_HEADS_NA = HALF // HEAD_DIM
WIN_H = 8
WIN_W = 16
Q_COLS = 16
K_COLS = Q_COLS + WIN_W
CTX_Q_BLOCK = 128
SSM_GROUP = 16
N_SSM_GROUPS = HALF // SSM_GROUP
SSM_STATE = 64
D_FF = 4 * D_MODEL
N_EVEN = (DEPTH + 1) // 2
N_ODD = DEPTH // 2
EPS = 1e-6

kernel_name = "hybrid_dit_pool_conv_natten_s5_step"


def rmsnorm(x, g):
    xf = x.astype(jnp.float32)
    y = xf * lax.rsqrt(jnp.mean(xf * xf, axis=-1, keepdims=True) + EPS)
    return (y * g.astype(jnp.float32)).astype(x.dtype)


def adaln(cond, w, b):
    m = jax.nn.silu(cond) @ w + b
    return m.reshape(cond.shape[:-1] + (1, 6, D_MODEL))


def modulate(h, shift, scale):
    return h * (1 + scale) + shift


def sqrelu_mlp(h, w1, w2):
    return jnp.square(jax.nn.relu(h @ w1)) @ w2


def to_heads(z):
    b, t, _ = z.shape
    return z.reshape(b, t, N_HEADS_NA, HEAD_DIM).transpose(0, 2, 1, 3)


def from_heads(z):
    b, h, t, d = z.shape
    return z.transpose(0, 2, 1, 3).reshape(b, t, h * d)


def pool_mixer(u, w_grp, scale):
    b, t, _ = u.shape
    uf = u.astype(jnp.float32)
    cs = jnp.concatenate([jnp.zeros((b, 1, HALF), jnp.float32), jnp.cumsum(uf, axis=1)], axis=1)
    pos = jnp.arange(t)
    outs = []
    for gi, w in enumerate(POOL_WINDOWS):
        lo = jnp.maximum(pos - w // 2, 0)
        hi = jnp.minimum(pos + (w - w // 2), t)
        sl = slice(gi * POOL_GROUP, (gi + 1) * POOL_GROUP)
        cnt = (hi - lo).astype(jnp.float32)[None, :, None]
        outs.append((cs[:, hi, sl] - cs[:, lo, sl]) / cnt - uf[:, :, sl])
    pooled = jnp.stack(outs, axis=2).astype(u.dtype)
    mixed = jnp.einsum('btgc,gcd->btgd', pooled, w_grp)
    return mixed.reshape(b, t, HALF) * scale


def short_conv_mixer(b_gate, c_gate, v_in, conv_w):
    z = c_gate * v_in
    t = z.shape[1]
    pad = (CONV_WIDTH - 1) // 2
    zp = jnp.pad(z, ((0, 0), (pad, CONV_WIDTH - 1 - pad), (0, 0)))
    conv = sum(conv_w[j] * zp[:, j:j + t] for j in range(CONV_WIDTH))
    return b_gate * conv


def even_mixer(h, w_in, pool_w, pool_scale, conv_w, w_out):
    proj = h @ w_in
    a_in, b_gate, c_gate, v_in = jnp.split(proj, 4, axis=-1)
    ya = pool_mixer(a_in, pool_w, pool_scale)
    yb = short_conv_mixer(b_gate, c_gate, v_in, conv_w)
    return jnp.concatenate([ya, yb], axis=-1) @ w_out


def context_attention(q, k, v):
    b, h, l, dh = q.shape
    scale = HEAD_DIM ** -0.5
    qb = q.reshape(b, h, l // CTX_Q_BLOCK, CTX_Q_BLOCK, dh).transpose(2, 0, 1, 3, 4)

    def one_block(qi):
        s = jnp.einsum('bhqd,bhkd->bhqk', qi, k).astype(jnp.float32) * scale
        p = jax.nn.softmax(s, axis=-1).astype(v.dtype)
        return jnp.einsum('bhqk,bhkd->bhqd', p, v)

    o = lax.map(one_block, qb)
    return o.transpose(1, 2, 0, 3, 4).reshape(b, h, l, dh)


def neighbourhood_attention(q, k, v, k_ctx, v_ctx, rpb):
    b, h, t, dh = q.shape
    rows = t // GRID_W
    kh = min(WIN_H, rows)
    ncb = GRID_W // Q_COLS
    scale = HEAD_DIM ** -0.5
    r = jnp.arange(rows)
    r0 = jnp.clip(r - kh // 2, 0, rows - kh)
    key_rows = r0[:, None] + jnp.arange(kh)[None, :]
    cb = jnp.arange(ncb)
    s0 = jnp.clip(cb * Q_COLS - WIN_W // 2, 0, GRID_W - K_COLS)
    key_cols = s0[:, None] + jnp.arange(K_COLS)[None, :]
    qcol = cb[:, None] * Q_COLS + jnp.arange(Q_COLS)[None, :]
    c0 = jnp.clip(qcol - WIN_W // 2, 0, GRID_W - WIN_W)
    kc = key_cols[:, None, :]
    col_valid = (kc >= c0[:, :, None]) & (kc < c0[:, :, None] + WIN_W)
    col_off = jnp.clip(kc - qcol[:, :, None], -(WIN_W - 1), WIN_W - 1)
    row_off = key_rows - r[:, None]
    bias = rpb.astype(jnp.float32)[:, row_off[:, None, None, :, None] + (WIN_H - 1),
                                   col_off[None, :, :, None, :] + (WIN_W - 1)]
    bias = jnp.where(col_valid[None, None, :, :, None, :], bias, -jnp.inf)

    qg = q.reshape(b, h, rows, ncb, Q_COLS, dh)
    kg = k.reshape(b, h, rows, GRID_W, dh)
    vg = v.reshape(b, h, rows, GRID_W, dh)
    ridx = key_rows[:, None, :, None]
    cidx = key_cols[None, :, None, :]
    k_blk = kg[:, :, ridx, cidx]
    v_blk = vg[:, :, ridx, cidx]

    s_loc = jnp.einsum('bhrcqd,bhrcyxd->bhrcqyx', qg, k_blk).astype(jnp.float32) * scale + bias
    s_ctx = jnp.einsum('bhrcqd,bhld->bhrcql', qg, k_ctx).astype(jnp.float32) * scale
    n_loc = kh * K_COLS
    s = jnp.concatenate([s_loc.reshape(b, h, rows, ncb, Q_COLS, n_loc), s_ctx], axis=-1)
    p = jax.nn.softmax(s, axis=-1).astype(v.dtype)
    p_loc = p[..., :n_loc].reshape(b, h, rows, ncb, Q_COLS, kh, K_COLS)
    out = (jnp.einsum('bhrcqyx,bhrcyxd->bhrcqd', p_loc, v_blk)
           + jnp.einsum('bhrcql,bhld->bhrcqd', p[..., n_loc:], v_ctx))
    return out.reshape(b, h, t, dh)


def _linear_recurrence(e1, e2):
    a1, b1 = e1
    a2, b2 = e2
    return a2 * a1, a2 * b1 + b2


def s5_bidirectional(u, s_re, s_im, lam_re, lam_im, log_step, b_re, b_im, c_re, c_im, d, glu_w, glu_b):
    bsz, t, _ = u.shape
    f32 = jnp.float32
    uc = u.astype(f32).reshape(bsz, t, N_SSM_GROUPS, SSM_GROUP).astype(jnp.complex64)
    y = d.astype(f32) * u.astype(f32)
    fin_re, fin_im = [], []
    for direction in range(2):
        reverse = direction == 1
        lam = lax.complex(lam_re[direction].astype(f32), lam_im[direction].astype(f32))
        step = jnp.exp(log_step[direction].astype(f32))[:, None]
        lam_bar = jnp.exp(lam * step)
        b_mat = lax.complex(b_re[direction].astype(f32), b_im[direction].astype(f32))
        b_bar = ((lam_bar - 1.0) / lam)[..., None] * b_mat
        c_mat = lax.complex(c_re[direction].astype(f32), c_im[direction].astype(f32))
        s0 = lax.complex(s_re[:, direction].astype(f32), s_im[:, direction].astype(f32))
        bu = jnp.einsum('npg,btng->btnp', b_bar, uc)
        first, last = (t - 1, 0) if reverse else (0, t - 1)
        bu = bu.at[:, first].add(lam_bar * s0)
        a = jnp.broadcast_to(lam_bar, bu.shape)
        _, states = lax.associative_scan(_linear_recurrence, (a, bu), axis=1, reverse=reverse)
        y = y + jnp.einsum('ngp,btnp->btng', c_mat, states).real.reshape(bsz, t, HALF)
        fin = states[:, last]
        fin_re.append(fin.real)
        fin_im.append(fin.imag)
    y = jax.nn.gelu(y).astype(u.dtype)
    y = y * jax.nn.sigmoid(y @ glu_w + glu_b)
    return y, jnp.stack(fin_re, axis=1), jnp.stack(fin_im, axis=1)


def setup_inputs(seed: int = 0) -> dict:
    key = jax.random.key(seed)
    ks = iter(jax.random.split(key, 40))
    nrm = lambda shape, s=1.0: s * jax.random.normal(next(ks), shape, jnp.float32)
    n = jnp.arange(SSM_STATE, dtype=jnp.float32)
    lam_im = jnp.broadcast_to(math.pi * n, (N_ODD, 2, N_SSM_GROUPS, SSM_STATE))
    return {
        "x_prompt": nrm((BATCH, SEQ, D_MODEL)),
        "x_sample": nrm((DEC_BATCH, DEC_SEQ, D_MODEL)),
        "c": nrm((DEC_BATCH, D_MODEL)),
        "cache_k": nrm((DEC_BATCH, N_ODD, N_HEADS_NA, PAST_LEN, HEAD_DIM)),
        "cache_v": nrm((DEC_BATCH, N_ODD, N_HEADS_NA, PAST_LEN, HEAD_DIM)),
        "state_s5_re": nrm((DEC_BATCH, N_ODD, 2, N_SSM_GROUPS, SSM_STATE), 0.1),
        "state_s5_im": nrm((DEC_BATCH, N_ODD, 2, N_SSM_GROUPS, SSM_STATE), 0.1),
        "c_ctx": nrm((D_MODEL,)),
        "norm1_g": 1.0 + nrm((DEPTH, D_MODEL), 0.02),
        "norm2_g": 1.0 + nrm((DEPTH, D_MODEL), 0.02),
        "ada_w": nrm((DEPTH, D_MODEL, 6 * D_MODEL), 0.5 * D_MODEL ** -0.5),
        "ada_b": nrm((DEPTH, 6 * D_MODEL), 0.02),
        "mlp_w1": nrm((DEPTH, D_MODEL, D_FF), D_MODEL ** -0.5),
        "mlp_w2": nrm((DEPTH, D_FF, D_MODEL), D_FF ** -0.5),
        "ab_w_in": nrm((N_EVEN, D_MODEL, 4 * HALF), D_MODEL ** -0.5),
        "pool_w": nrm((N_EVEN, len(POOL_WINDOWS), POOL_GROUP, POOL_GROUP), POOL_GROUP ** -0.5),
        "pool_scale": 1.0 + nrm((N_EVEN, HALF), 0.05),
        "conv_w": nrm((N_EVEN, CONV_WIDTH, HALF), CONV_WIDTH ** -0.5),
        "ab_w_out": nrm((N_EVEN, MIX_WIDTH, D_MODEL), MIX_WIDTH ** -0.5),
        "cd_w_in": nrm((N_ODD, D_MODEL, 4 * HALF), D_MODEL ** -0.5),
        "na_rpb": nrm((N_ODD, N_HEADS_NA, 2 * WIN_H - 1, 2 * WIN_W - 1), 0.1),
        "ssm_lambda_re": -0.5 + nrm((N_ODD, 2, N_SSM_GROUPS, SSM_STATE), 0.01),
        "ssm_lambda_im": lam_im + nrm((N_ODD, 2, N_SSM_GROUPS, SSM_STATE), 0.01),
        "ssm_log_step": jax.random.uniform(next(ks), (N_ODD, 2, N_SSM_GROUPS), jnp.float32,
                                           math.log(1e-3), math.log(1e-1)),
        "ssm_b_re": nrm((N_ODD, 2, N_SSM_GROUPS, SSM_STATE, SSM_GROUP), (2 * SSM_GROUP) ** -0.5),
        "ssm_b_im": nrm((N_ODD, 2, N_SSM_GROUPS, SSM_STATE, SSM_GROUP), (2 * SSM_GROUP) ** -0.5),
        "ssm_c_re": nrm((N_ODD, 2, N_SSM_GROUPS, SSM_GROUP, SSM_STATE), (2 * SSM_STATE) ** -0.5),
        "ssm_c_im": nrm((N_ODD, 2, N_SSM_GROUPS, SSM_GROUP, SSM_STATE), (2 * SSM_STATE) ** -0.5),
        "ssm_d": nrm((N_ODD, HALF)),
        "glu_w": nrm((N_ODD, HALF, HALF), HALF ** -0.5),
        "glu_b": nrm((N_ODD, HALF), 0.02),
        "cd_w_out": nrm((N_ODD, MIX_WIDTH, D_MODEL), MIX_WIDTH ** -0.5),
        "final_g": 1.0 + nrm((D_MODEL,), 0.02),
    }


def reference(x_prompt, x_sample, c, cache_k, cache_v, state_s5_re, state_s5_im, c_ctx,
              norm1_g, norm2_g, ada_w, ada_b, mlp_w1, mlp_w2,
              ab_w_in, pool_w, pool_scale, conv_w, ab_w_out,
              cd_w_in, na_rpb, ssm_lambda_re, ssm_lambda_im, ssm_log_step,
              ssm_b_re, ssm_b_im, ssm_c_re, ssm_c_im, ssm_d, glu_w, glu_b, cd_w_out,
              final_g):
    xp, xs = x_prompt, x_sample
    new_k, new_v, new_re, new_im = [], [], [], []
    for layer in range(DEPTH):
        mod_p = adaln(c_ctx, ada_w[layer], ada_b[layer])
        mod_s = adaln(c, ada_w[layer], ada_b[layer])
        hp = modulate(rmsnorm(xp, norm1_g[layer]), mod_p[..., 0, :], mod_p[..., 1, :])
        hs = modulate(rmsnorm(xs, norm1_g[layer]), mod_s[..., 0, :], mod_s[..., 1, :])
        i = layer // 2
        if layer % 2 == 0:
            yp = even_mixer(hp, ab_w_in[i], pool_w[i], pool_scale[i], conv_w[i], ab_w_out[i])
            ys = even_mixer(hs, ab_w_in[i], pool_w[i], pool_scale[i], conv_w[i], ab_w_out[i])
        else:
            ssm_args = (ssm_lambda_re[i], ssm_lambda_im[i], ssm_log_step[i], ssm_b_re[i], ssm_b_im[i],
                        ssm_c_re[i], ssm_c_im[i], ssm_d[i], glu_w[i], glu_b[i])
            q_p, k_p, v_p, u_p = jnp.split(hp @ cd_w_in[i], 4, axis=-1)
            k_ph, v_ph = to_heads(k_p), to_heads(v_p)
            o_p = from_heads(context_attention(to_heads(q_p), k_ph, v_ph))
            zero_state = jnp.zeros((xp.shape[0], 2, N_SSM_GROUPS, SSM_STATE), jnp.float32)
            d_p, fin_re, fin_im = s5_bidirectional(u_p, zero_state, zero_state, *ssm_args)
            yp = jnp.concatenate([o_p, d_p], axis=-1) @ cd_w_out[i]
            new_k.append(k_ph)
            new_v.append(v_ph)
            new_re.append(fin_re)
            new_im.append(fin_im)
            q_s, k_s, v_s, u_s = jnp.split(hs @ cd_w_in[i], 4, axis=-1)
            o_s = from_heads(neighbourhood_attention(to_heads(q_s), to_heads(k_s), to_heads(v_s),
                                                     cache_k[:, i], cache_v[:, i], na_rpb[i]))
            d_s, _, _ = s5_bidirectional(u_s, state_s5_re[:, i], state_s5_im[:, i], *ssm_args)
            ys = jnp.concatenate([o_s, d_s], axis=-1) @ cd_w_out[i]
        xp = xp + mod_p[..., 2, :] * yp
        xs = xs + mod_s[..., 2, :] * ys
        hp = modulate(rmsnorm(xp, norm2_g[layer]), mod_p[..., 3, :], mod_p[..., 4, :])
        hs = modulate(rmsnorm(xs, norm2_g[layer]), mod_s[..., 3, :], mod_s[..., 4, :])
        xp = xp + mod_p[..., 5, :] * sqrelu_mlp(hp, mlp_w1[layer], mlp_w2[layer])
        xs = xs + mod_s[..., 5, :] * sqrelu_mlp(hs, mlp_w1[layer], mlp_w2[layer])
    y_prompt = rmsnorm(xp, final_g)
    y_sample = rmsnorm(xs, final_g)
    new_cache_k = jnp.stack(new_k, axis=1)
    new_cache_v = jnp.stack(new_v, axis=1)
    new_state_re = jnp.stack(new_re, axis=1)
    new_state_im = jnp.stack(new_im, axis=1)
    return (y_prompt, y_sample, new_cache_k, new_cache_v, new_state_re, new_state_im)
```

```cpp
#include <hip/hip_runtime.h>
#include <hip/hip_cooperative_groups.h>
#include <cstdio>
#include <cstdint>
namespace cg = cooperative_groups;

#ifndef MK_N_LAUNCHES
#define MK_N_LAUNCHES 1
#endif

#define LAS __attribute__((address_space(3)))
typedef unsigned short bf16;
typedef short bf16x8 __attribute__((ext_vector_type(8)));
typedef float f32x4 __attribute__((ext_vector_type(4)));
typedef float f32x2 __attribute__((ext_vector_type(2)));
typedef unsigned u32x4 __attribute__((ext_vector_type(4)));
typedef unsigned u32x2 __attribute__((ext_vector_type(2)));

constexpr int D = 1024, NP = 4096, NS = 8192, NTOK = 12288, FF = 4096;
constexpr int NTHR = 512, NWAVES = 8;
constexpr float EPS = 1e-6f;
constexpr int LDS_BYTES = 131072 + 256 + 8192 + 15360;
constexpr int LDS_XOFF = 131072 + 256, LDS_RPB = LDS_XOFF + 8192;
constexpr int NPHASES = 19;
constexpr int QP = 1664, VPP = 384, VSP = 2176;

constexpr size_t MiB = 1u << 20;
constexpr size_t WS_MODS = 0;
constexpr size_t WS_LPOW = 256 * 1024;
constexpr size_t WS_BBAR = 1 * MiB;
constexpr size_t WS_KTAB = 2 * MiB;
constexpr size_t WS_KC = 3 * MiB;
constexpr size_t WS_VTC = 216 * MiB;
constexpr size_t WS_WIN0 = 5 * MiB, WS_WOUT0 = 9 * MiB, WS_W1_0 = 11 * MiB, WS_W2_0 = 19 * MiB;
constexpr size_t WS_WIN1 = 27 * MiB, WS_WOUT1 = 31 * MiB, WS_W1_1 = 33 * MiB, WS_W2_1 = 41 * MiB;
constexpr size_t WS_GLUT = 49 * MiB;
constexpr size_t WS_BMAT = 50 * MiB;
constexpr size_t WS_FMAT = 58 * MiB;
constexpr size_t WS_H = 66 * MiB;
constexpr size_t WS_R = 90 * MiB;
constexpr size_t WS_Z = WS_R + 48 * MiB;
constexpr size_t WS_ABUF = WS_R + 72 * MiB;
constexpr size_t WS_YBUF = 186 * MiB;
constexpr size_t WS_VTP = 198 * MiB;
constexpr size_t WS_VTS = 204 * MiB;
constexpr size_t WS_TAB = 213 * MiB;
constexpr size_t WS_BAR = 214 * MiB;
constexpr size_t WS_XBUF = 215 * MiB;
constexpr size_t WS_END = 218 * MiB;
constexpr int CNT_OFF_WORDS = 4096;

constexpr size_t O_K = (size_t)NTOK * D, O_V = O_K + 2097152, O_SRE = O_V + 2097152, O_SIM = O_SRE + 65536;

__device__ __forceinline__ unsigned cvt_pk_bf16(float lo, float hi) { unsigned r; asm volatile("v_cvt_pk_bf16_f32 %0, %1, %2" : "=v"(r) : "v"(lo), "v"(hi)); return r; }
__device__ __forceinline__ float bf_lo(unsigned u) { return __uint_as_float(u << 16); }
__device__ __forceinline__ float bf_hi(unsigned u) { return __uint_as_float(u & 0xffff0000u); }
__device__ __forceinline__ float wave_sum(float v) {
#pragma unroll
    for (int o = 1; o < 64; o <<= 1) v += __shfl_xor(v, o);
    return v;
}
__device__ __forceinline__ int lane_id() { int l; asm volatile("v_mbcnt_lo_u32_b32 %0, -1, 0\n\tv_mbcnt_hi_u32_b32 %0, -1, %0" : "=v"(l)); return l; }
__device__ __forceinline__ float fast_exp(float x) { return __builtin_amdgcn_exp2f(x * 1.44269504089f); }
__device__ __forceinline__ float sigmoidf_(float x) { return 1.0f / (1.0f + fast_exp(-x)); }
__device__ __forceinline__ float gelu_tanh(float y) {
    const float a = 0.7978845608f * (y + 0.044715f * y * y * y);
    const float t = 1.0f - 2.0f / (1.0f + fast_exp(2.0f * a));
    return 0.5f * y * (1.0f + t);
}
__device__ __forceinline__ void unpack8(const u32x4 u, float (&f)[8]) {
    f[0] = bf_lo(u.x); f[1] = bf_hi(u.x); f[2] = bf_lo(u.y); f[3] = bf_hi(u.y); f[4] = bf_lo(u.z); f[5] = bf_hi(u.z); f[6] = bf_lo(u.w); f[7] = bf_hi(u.w);
}
__device__ __forceinline__ u32x4 pack8(const float (&f)[8]) {
    u32x4 w; w.x = cvt_pk_bf16(f[0], f[1]); w.y = cvt_pk_bf16(f[2], f[3]); w.z = cvt_pk_bf16(f[4], f[5]); w.w = cvt_pk_bf16(f[6], f[7]); return w;
}
__device__ __forceinline__ int cond_of_row(int r) { return r < NP ? 4 : ((r - NP) >> 11); }

namespace pg8 {
typedef unsigned short bf16_t;
constexpr int BM = 256, BK = 64, HALF = 128, HTB = HALF * BK * 2, STAGE_BYTES = 8 * HTB, NXCD = 8, WGM = 8;
__host__ __device__ __forceinline__ int lds_byte(int r, int c) { const int st = (r >> 4) * 2 + (c >> 5), rr = r & 15, cc = c & 31, ob = rr * 64 + cc * 2; return st * 1024 + (ob ^ (((ob >> 9) & 1) << 5)); }
__host__ __device__ __forceinline__ void stage_rc(int b, int& R, int& C) { const int st = b / 1024, sb = b % 1024, swz = sb ^ (((sb >> 9) & 1) << 5); R = (st >> 1) * 16 + swz / 64; C = (st & 1) * 32 + (swz % 64) / 2; }
__host__ __device__ __forceinline__ int perm32(int rho) { const int n = rho >> 4, i = rho & 15; return 8 * (i >> 2) + 4 * n + (i & 3); }

struct Unit { int pm, pn; };
struct Gemm { const bf16_t* A; const bf16_t* Bt; int lda, ldb, K; };

struct Sched {
    int nM, nN, nwg, G, c, mode;
    __device__ void init(int nM_, int nN_, int G_, int c_, int mode_) { nM = nM_; nN = nN_; nwg = nM * nN; G = G_; c = c_; mode = mode_; }
    __device__ bool next(int i, Unit& u) const {
        const long L = (long)i * G + c; if (L >= nwg) return false;
        if (mode == 2) { u.pm = (int)L; u.pn = (int)L / 3; return true; }
        if (mode == 3) { const int x = (int)L & 7, k = (int)L >> 3; u.pm = x + 8 * (k >> 2); u.pn = k & 3; return true; }
        int wgid = (int)L; { const int q = nwg / NXCD, r = nwg % NXCD, xcd = wgid % NXCD, off = wgid / NXCD; wgid = (xcd < r ? xcd * (q + 1) : r * (q + 1) + (xcd - r) * q) + off; }
        const int nig = WGM * nN, gid = wgid / nig, fm = gid * WGM, gsz = (nM - fm) < WGM ? (nM - fm) : WGM;
        u.pm = fm + ((wgid % nig) % gsz); u.pn = (wgid % nig) / gsz;
        if (mode == 1 && u.pn >= 4) u.pn += 2;
        return true;
    }
};

template <class T, class = void> struct is_fused { static constexpr bool value = false; };
template <class T> struct is_fused<T, decltype((void)T::FUSED)> { static constexpr bool value = true; };
template <class Epi>
__device__ __forceinline__ void gemm_phase(LAS unsigned char* lds, const int wid, const Gemm g, const Sched& S, const Epi& E) {
    const int lane = lane_id(), tid = wid * 64 + lane, wr = wid >> 2, wc = wid & 3, fr = lane & 15, fq = lane >> 4;
    const int K = g.K, nt = K / BK;
    unsigned voffA[2], voffB[2];
#pragma unroll
    for (int i = 0; i < 2; ++i) { int R, C; stage_rc(tid * 16 + i * 8192, R, C); const int Rb = (R & ~31) + perm32(R & 31);
        voffA[i] = (unsigned)(R * g.lda + C) * 2u; voffB[i] = (unsigned)(Rb * g.ldb + C) * 2u; }
    const size_t kstep = (size_t)(BK * 2);
    const size_t hA = (size_t)HALF * g.lda * 2, hB = (size_t)HALF * g.ldb * 2;
    const size_t tA = 2 * hA, tB = 2 * hB;
    const unsigned ldsw = (unsigned)wid * 1024u;
    const int aoff = lds_byte(wr * 64 + fr, fq * 8), boff = lds_byte(wc * 32 + fr, fq * 8);
#define PG8_SA(b, h) (((b) * 2 + (h)) * HTB)
#define PG8_SB(b, h) ((4 + (b) * 2 + (h)) * HTB)
#define PG8_STAGE(bufoff, gbase, voff) do { _Pragma("unroll") for (int _i = 0; _i < 2; ++_i) \
        __builtin_amdgcn_global_load_lds((const unsigned*)((const char*)(gbase) + (voff)[_i]), (LAS unsigned*)(lds + (bufoff) + ldsw + _i * 8192), 16, 0, 0); } while (0)
#define PG8_LDA(dst, b, h) do { _Pragma("unroll") for (int m = 0; m < 4; ++m) _Pragma("unroll") for (int k = 0; k < 2; ++k) dst[m][k] = *(const LAS bf16x8*)(lds + PG8_SA(b, h) + aoff + m * 2048 + k * 1024); } while (0)
#define PG8_LDB(dst, b, h) do { _Pragma("unroll") for (int n = 0; n < 2; ++n) _Pragma("unroll") for (int k = 0; k < 2; ++k) dst[n][k] = *(const LAS bf16x8*)(lds + PG8_SB(b, h) + boff + n * 2048 + k * 1024); } while (0)
#define PG8_MMA(ai, bj, At, Bt) do { __builtin_amdgcn_s_setprio(1); _Pragma("unroll") for (int m = 0; m < 4; ++m) _Pragma("unroll") for (int n = 0; n < 2; ++n) _Pragma("unroll") for (int k = 0; k < 2; ++k) \
        acc[ai][bj][m][n] = __builtin_amdgcn_mfma_f32_16x16x32_bf16(Bt[n][k], At[m][k], acc[ai][bj][m][n], 0, 0, 0); __builtin_amdgcn_s_setprio(0); } while (0)
#define PG8_WAIT_V(n) asm volatile("s_waitcnt vmcnt(" #n ")" ::: "memory")
#define PG8_WAIT_L(n) asm volatile("s_waitcnt lgkmcnt(" #n ")" ::: "memory")
#define PG8_BAR __builtin_amdgcn_s_barrier()
#define PG8_SCHED __builtin_amdgcn_sched_barrier(0)
    Unit cur, nxt; int ui = 0;
    if (!S.next(0, cur)) return;
    f32x4 acc[2][2][4][2];
#pragma unroll
    for (int a = 0; a < 2; ++a)
#pragma unroll
        for (int b = 0; b < 2; ++b)
#pragma unroll
            for (int m = 0; m < 4; ++m)
#pragma unroll
                for (int n = 0; n < 2; ++n) acc[a][b][m][n] = (f32x4){0.f, 0.f, 0.f, 0.f};
    bf16x8 At[4][2], B0[2][2], B1[2][2];
    const char* cA = (const char*)g.A + (size_t)cur.pm * tA; const char* cB = (const char*)g.Bt + (size_t)cur.pn * tB;
    PG8_STAGE(PG8_SB(0, 0), cB, voffB); PG8_STAGE(PG8_SB(0, 1), cB + hB, voffB); PG8_STAGE(PG8_SA(0, 0), cA, voffA); PG8_STAGE(PG8_SA(0, 1), cA + hA, voffA);
    if (wr == 1) PG8_BAR;
    PG8_WAIT_V(2); PG8_BAR;
    PG8_STAGE(PG8_SB(1, 0), cB + kstep, voffB); PG8_STAGE(PG8_SA(1, 0), cA + kstep, voffA); PG8_STAGE(PG8_SB(1, 1), cB + hB + kstep, voffB);
    PG8_WAIT_V(6); PG8_BAR;
    for (;;) {
        const bool has_next = S.next(ui + 1, nxt);
        const char* nA = has_next ? (const char*)g.A + (size_t)nxt.pm * tA : cA; const char* nB = has_next ? (const char*)g.Bt + (size_t)nxt.pn * tB : cB;
        for (int t = 0; t < nt; t += 2) {
            const bool last = (t == nt - 2);
            const char* a1 = cA + (size_t)(t + 1) * kstep;
            const char* a2 = last ? nA : cA + (size_t)(t + 2) * kstep; const char* b2 = last ? nB : cB + (size_t)(t + 2) * kstep;
            const char* a3 = a2 + kstep; const char* b3 = b2 + kstep;
            PG8_LDB(B0, 0, 0); PG8_LDB(B1, 0, 1); PG8_SCHED; PG8_LDA(At, 0, 0); PG8_STAGE(PG8_SA(1, 1), a1 + hA, voffA);
            PG8_WAIT_V(8); PG8_WAIT_L(0); PG8_BAR; PG8_MMA(0, 0, At, B0); PG8_MMA(0, 1, At, B1); PG8_BAR; PG8_SCHED;
            PG8_LDA(At, 0, 1); PG8_STAGE(PG8_SB(0, 0), b2, voffB); PG8_STAGE(PG8_SB(0, 1), b2 + hB, voffB); PG8_STAGE(PG8_SA(0, 0), a2, voffA);
            PG8_WAIT_V(8); PG8_WAIT_L(0); PG8_BAR; PG8_MMA(1, 0, At, B0); PG8_MMA(1, 1, At, B1); PG8_BAR; PG8_SCHED;
            PG8_LDB(B0, 1, 0); PG8_LDB(B1, 1, 1); PG8_SCHED; PG8_LDA(At, 1, 0); PG8_STAGE(PG8_SA(0, 1), a2 + hA, voffA);
            PG8_WAIT_V(8); PG8_WAIT_L(0); PG8_BAR; PG8_MMA(0, 0, At, B0); PG8_MMA(0, 1, At, B1); PG8_BAR; PG8_SCHED;
            PG8_LDA(At, 1, 1); PG8_STAGE(PG8_SB(1, 0), b3, voffB); PG8_STAGE(PG8_SB(1, 1), b3 + hB, voffB); PG8_STAGE(PG8_SA(1, 0), a3, voffA);
            PG8_WAIT_V(8); PG8_WAIT_L(0); PG8_BAR; PG8_MMA(1, 0, At, B0); PG8_MMA(1, 1, At, B1); PG8_BAR; PG8_SCHED;
        }
        if (wr == 0) PG8_BAR;
        if constexpr (is_fused<Epi>::value) E.fused(acc, cur, wr, wc, fr, fq, wid, lane); else E(acc, cur, wr, wc, fr, fq);
        if (!has_next) break;
#pragma unroll
        for (int a = 0; a < 2; ++a)
#pragma unroll
            for (int b = 0; b < 2; ++b)
#pragma unroll
                for (int m = 0; m < 4; ++m)
#pragma unroll
                    for (int n = 0; n < 2; ++n) acc[a][b][m][n] = (f32x4){0.f, 0.f, 0.f, 0.f};
        cur = nxt; cA = nA; cB = nB; ++ui;
        if (wr == 1) PG8_BAR;
    }
    PG8_WAIT_V(0);
    PG8_BAR;
#undef PG8_SA
#undef PG8_SB
#undef PG8_STAGE
#undef PG8_LDA
#undef PG8_LDB
#undef PG8_MMA
#undef PG8_WAIT_V
#undef PG8_WAIT_L
#undef PG8_BAR
#undef PG8_SCHED
}

template <int ACT  > struct EpiStore {
    bf16_t* O; int ldc;
    __device__ __forceinline__ void operator()(const f32x4 (&acc)[2][2][4][2], const Unit& u, int wr, int wc, int fr, int fq) const {
        const int row0 = u.pm * BM + wr * 64 + fr, col0 = u.pn * BM + wc * 32 + 8 * fq;
#pragma unroll
        for (int ai = 0; ai < 2; ++ai)
#pragma unroll
            for (int m = 0; m < 4; ++m) { bf16_t* rowp = O + (size_t)(row0 + ai * HALF + m * 16) * ldc + col0;
#pragma unroll
                for (int bj = 0; bj < 2; ++bj) { f32x4 v0 = acc[ai][bj][m][0], v1 = acc[ai][bj][m][1];
                    if (ACT == 1) {
#pragma unroll
                        for (int i = 0; i < 4; ++i) { const float a = fmaxf(v0[i], 0.f), b = fmaxf(v1[i], 0.f); v0[i] = a * a; v1[i] = b * b; } }
                    u32x4 w; w.x = cvt_pk_bf16(v0[0], v0[1]); w.y = cvt_pk_bf16(v0[2], v0[3]); w.z = cvt_pk_bf16(v1[0], v1[1]); w.w = cvt_pk_bf16(v1[2], v1[3]);
                    *(u32x4*)(rowp + bj * HALF) = w; } }
    }
};
struct EpiResGate {
    const float* xp; const float* xs; float* out; const float* gates;
    __device__ __forceinline__ void operator()(const f32x4 (&acc)[2][2][4][2], const Unit& u, int wr, int wc, int fr, int fq) const {
        const int rb = u.pm * BM; const float* gate = gates + cond_of_row(rb) * 6144;
        const float* base = xp ? (rb < NP ? xp : xs - (size_t)NP * D) : out;
        const int row0 = rb + wr * 64 + fr, col0 = u.pn * BM + wc * 32 + 8 * fq;
        f32x4 gv[2][2];
#pragma unroll
        for (int bj = 0; bj < 2; ++bj)
#pragma unroll
            for (int n = 0; n < 2; ++n) gv[bj][n] = *(const f32x4*)(gate + col0 + bj * HALF + 4 * n);
#pragma unroll
        for (int ai = 0; ai < 2; ++ai)
#pragma unroll
            for (int m = 0; m < 4; ++m) { const size_t ro = (size_t)(row0 + ai * HALF + m * 16) * D + col0;
#pragma unroll
                for (int bj = 0; bj < 2; ++bj)
#pragma unroll
                    for (int n = 0; n < 2; ++n) { const f32x4 b = *(const f32x4*)(base + ro + bj * HALF + 4 * n);
                        *(f32x4*)(out + ro + bj * HALF + 4 * n) = b + gv[bj][n] * acc[ai][bj][m][n]; } }
    }
};
struct EpiResGateNorm {
    static constexpr bool FUSED = true;
    const float* xp; const float* xs; float* out; const float* gates;
    const float* gam; const float* modn; int sidx; bf16_t* Hn;
    float* xbuf; unsigned* cnt; LAS unsigned char* l2;
    __device__ __forceinline__ void fused(f32x4 (&acc)[2][2][4][2], const Unit& u, int wr, int wc, int fr, int fq, int wid, int lane) const {
        LAS float* P = (LAS float*)l2;
        LAS float* S = (LAS float*)(l2 + 4096);
        const int rb = u.pm * BM; const int cnd = cond_of_row(rb); const float* gate = gates + cnd * 6144;
        const float* base = xp ? (rb < NP ? xp : xs - (size_t)NP * D) : out;
        const int row0 = rb + wr * 64 + fr, col0 = u.pn * BM + wc * 32 + 8 * fq;
        {
            f32x4 gv[2][2];
#pragma unroll
            for (int bj = 0; bj < 2; ++bj)
#pragma unroll
                for (int n = 0; n < 2; ++n) gv[bj][n] = *(const f32x4*)(gate + col0 + bj * HALF + 4 * n);
#pragma unroll
            for (int am = 0; am < 4; ++am) {
                const int ai = am >> 1, m0 = (am & 1) * 2;
                f32x4 bb[2][2][2];
#pragma unroll
                for (int mm = 0; mm < 2; ++mm)
#pragma unroll
                    for (int bj = 0; bj < 2; ++bj)
#pragma unroll
                        for (int n = 0; n < 2; ++n) bb[mm][bj][n] = *(const f32x4*)(base + (size_t)(row0 + ai * HALF + (m0 + mm) * 16) * D + col0 + bj * HALF + 4 * n);
#pragma unroll
                for (int mm = 0; mm < 2; ++mm) { const int m = m0 + mm; const size_t ro = (size_t)(row0 + ai * HALF + m * 16) * D + col0; float s = 0.f;
#pragma unroll
                    for (int bj = 0; bj < 2; ++bj)
#pragma unroll
                        for (int n = 0; n < 2; ++n) {
                            const f32x4 v = bb[mm][bj][n] + gv[bj][n] * acc[ai][bj][m][n]; acc[ai][bj][m][n] = v;
                            s += (v[0] * v[0] + v[1] * v[1]) + (v[2] * v[2] + v[3] * v[3]); }
                    s += __shfl_xor(s, 16); s += __shfl_xor(s, 32);
                    if (fq == 0) P[(ai * HALF + wr * 64 + m * 16 + fr) * 4 + wc] = s; }
            }
        }
        asm volatile("s_waitcnt lgkmcnt(0)" ::: "memory"); __builtin_amdgcn_s_barrier(); asm volatile("" ::: "memory");
        const int prow = wid * 32 + (lane & 31);
        if (lane < 32) {
            const float tot = (P[prow * 4 + 0] + P[prow * 4 + 1]) + (P[prow * 4 + 2] + P[prow * 4 + 3]);
            __hip_atomic_store(xbuf + ((size_t)(rb + prow) * 4 + u.pn), tot, __ATOMIC_RELAXED, __HIP_MEMORY_SCOPE_AGENT);
        }
        asm volatile("s_waitcnt vmcnt(0)" ::: "memory");
        if (lane == 0) __hip_atomic_fetch_add(cnt + 64 * u.pm, 1u, __ATOMIC_RELAXED, __HIP_MEMORY_SCOPE_AGENT);
        if (Hn) {
#pragma unroll
            for (int ai = 0; ai < 2; ++ai)
#pragma unroll
                for (int m = 0; m < 4; ++m) { float* op = out + (size_t)(row0 + ai * HALF + m * 16) * D + col0;
#pragma unroll
                    for (int bj = 0; bj < 2; ++bj)
#pragma unroll
                        for (int n = 0; n < 2; ++n) *(f32x4*)(op + bj * HALF + 4 * n) = acc[ai][bj][m][n]; }
        }
        if (wid == 0) {
            unsigned sp = 0;
            for (;;) {
                if ((unsigned)__builtin_amdgcn_readfirstlane(__hip_atomic_load(cnt + 64 * u.pm, __ATOMIC_RELAXED, __HIP_MEMORY_SCOPE_AGENT)) >= 32u) break;
                if (++sp > (1u << 20)) break;
                __builtin_amdgcn_s_sleep(2);
            }
            __builtin_amdgcn_fence(__ATOMIC_ACQUIRE, "agent");
        }
        asm volatile("s_waitcnt vmcnt(0) lgkmcnt(0)" ::: "memory"); __builtin_amdgcn_s_barrier(); asm volatile("" ::: "memory");
        if (lane < 32) {
            const float* slot = xbuf + (size_t)(rb + prow) * 4; float tot = 0.f;
#pragma unroll
            for (int t = 0; t < 4; ++t) tot += __hip_atomic_load(slot + t, __ATOMIC_RELAXED, __HIP_MEMORY_SCOPE_AGENT);
            S[prow] = 1.0f / sqrtf(tot * (1.0f / D) + EPS);
        }
        asm volatile("s_waitcnt vmcnt(0) lgkmcnt(0)" ::: "memory"); __builtin_amdgcn_s_barrier(); asm volatile("" ::: "memory");
        const float* sh = modn + cnd * 6144 + sidx * 1024; const float* sc = sh + 1024;
#pragma unroll
        for (int bj = 0; bj < 2; ++bj) {
            const int c = col0 + bj * HALF;
            f32x4 g0 = *(const f32x4*)(gam + c), g1 = *(const f32x4*)(gam + c + 4), h0 = (f32x4){0.f, 0.f, 0.f, 0.f}, h1 = h0;
            if (Hn) { g0 = g0 * (*(const f32x4*)(sc + c) + 1.0f); g1 = g1 * (*(const f32x4*)(sc + c + 4) + 1.0f); h0 = *(const f32x4*)(sh + c); h1 = *(const f32x4*)(sh + c + 4); }
#pragma unroll
            for (int ai = 0; ai < 2; ++ai)
#pragma unroll
                for (int m = 0; m < 4; ++m) { const int rl = ai * HALF + wr * 64 + m * 16 + fr; const float rstd = S[rl];
                    const f32x4 o0 = acc[ai][bj][m][0] * rstd * g0 + h0, o1 = acc[ai][bj][m][1] * rstd * g1 + h1;
                    if (Hn) { u32x4 w; w.x = cvt_pk_bf16(o0[0], o0[1]); w.y = cvt_pk_bf16(o0[2], o0[3]); w.z = cvt_pk_bf16(o1[0], o1[1]); w.w = cvt_pk_bf16(o1[2], o1[3]);
                        *(u32x4*)(Hn + (size_t)(rb + rl) * D + c) = w; }
                    else { float* o = out + (size_t)(rb + rl) * D + c; *(f32x4*)o = o0; *(f32x4*)(o + 4) = o1; } }
        }
    }
};
struct EpiProj1 {
    bf16_t* QKV; bf16_t* ABUF; float* outK;
    __device__ __forceinline__ void operator()(const f32x4 (&acc)[2][2][4][2], const Unit& u, int wr, int wc, int fr, int fq) const {
        const int row0 = u.pm * BM + wr * 64 + fr, col0 = u.pn * BM + wc * 32 + 8 * fq;
#pragma unroll
        for (int ai = 0; ai < 2; ++ai)
#pragma unroll
            for (int m = 0; m < 4; ++m) { const int r = row0 + ai * HALF + m * 16;
#pragma unroll
                for (int bj = 0; bj < 2; ++bj) { const int c = col0 + bj * HALF; const f32x4 v0 = acc[ai][bj][m][0], v1 = acc[ai][bj][m][1];
                    u32x4 w; w.x = cvt_pk_bf16(v0[0], v0[1]); w.y = cvt_pk_bf16(v0[2], v0[3]); w.z = cvt_pk_bf16(v1[0], v1[1]); w.w = cvt_pk_bf16(v1[2], v1[3]);
                    if (u.pn < 4) {
                        *(u32x4*)(QKV + (size_t)r * QP + c) = w;
                        if (u.pn >= 2 && r < NP) { const int b = r >> 8, t = r & 255, hh = (c - 512) >> 6, d = (c - 512) & 63;
                            float* o = outK + ((size_t)((b * 8 + hh) * 256 + t)) * 64 + d; *(f32x4*)o = v0; *(f32x4*)(o + 4) = v1; }
                    } else { const int cu = c - 1536, gg = cu >> 4, gi0 = cu & 15, chunk = r >> 4, j = r & 15;
                        *(u32x4*)(ABUF + ((size_t)(gg * 768 + chunk)) * 512 + j * 16 + gi0) = w; }
                } }
    }
};
struct EpiVT {
    bf16_t* VTP; bf16_t* VTS; float* outV;
    __device__ __forceinline__ void operator()(const f32x4 (&acc)[2][2][4][2], const Unit& u, int wr, int wc, int fr, int fq) const {
        const int row0 = u.pm * BM + wr * 64 + fr, col0 = u.pn * BM + wc * 32 + 8 * fq;
#pragma unroll
        for (int ai = 0; ai < 2; ++ai)
#pragma unroll
            for (int m = 0; m < 4; ++m) { const int c = row0 + ai * HALF + m * 16, hh = c >> 6, d = c & 63;
#pragma unroll
                for (int bj = 0; bj < 2; ++bj) { const int r0 = col0 + bj * HALF; const f32x4 v0 = acc[ai][bj][m][0], v1 = acc[ai][bj][m][1];
                    u32x4 w; w.x = cvt_pk_bf16(v0[0], v0[1]); w.y = cvt_pk_bf16(v0[2], v0[3]); w.z = cvt_pk_bf16(v1[0], v1[1]); w.w = cvt_pk_bf16(v1[2], v1[3]);
                    if (r0 < NP) { const int b = r0 >> 8, t0 = r0 & 255;
                        *(u32x4*)(VTP + ((size_t)((b * 8 + hh) * 64 + d)) * VPP + t0) = w;
                        float* o = outV + ((size_t)((b * 8 + hh) * 256 + t0)) * 64 + d;
#pragma unroll
                        for (int i = 0; i < 4; ++i) { o[i * 64] = v0[i]; o[(i + 4) * 64] = v1[i]; }
                    } else { const int rs = r0 - NP, b = rs >> 11, t0 = rs & 2047;
                        *(u32x4*)(VTS + ((size_t)((b * 8 + hh) * 64 + d)) * VSP + t0) = w; }
                } }
    }
};
struct EpiF {
    float* F;
    __device__ __forceinline__ void operator()(const f32x4 (&acc)[2][2][4][2], const Unit& u, int wr, int wc, int fr, int fq) const {
        const int row0 = u.pm * BM + wr * 64 + fr, col0 = wc * 32 + 8 * fq;
#pragma unroll
        for (int ai = 0; ai < 2; ++ai)
#pragma unroll
            for (int m = 0; m < 4; ++m) { float* rowp = F + (size_t)(row0 + ai * HALF + m * 16) * 256 + col0;
#pragma unroll
                for (int bj = 0; bj < 2; ++bj) { *(f32x4*)(rowp + bj * HALF) = acc[ai][bj][m][0]; *(f32x4*)(rowp + bj * HALF + 4) = acc[ai][bj][m][1]; } }
    }
};
struct EpiY {
    bf16_t* Y;
    __device__ __forceinline__ void operator()(const f32x4 (&acc)[2][2][4][2], const Unit& u, int wr, int wc, int fr, int fq) const {
        const int gg = u.pn, row0 = u.pm * BM + wr * 64 + fr - gg * 768, col0 = wc * 32 + 8 * fq;
#pragma unroll
        for (int ai = 0; ai < 2; ++ai)
#pragma unroll
            for (int m = 0; m < 4; ++m) { const int chunk = row0 + ai * HALF + m * 16;
#pragma unroll
                for (int bj = 0; bj < 2; ++bj) { const int n = col0 + bj * HALF, t = n >> 4, go0 = n & 15; const f32x4 v0 = acc[ai][bj][m][0], v1 = acc[ai][bj][m][1];
                    u32x4 w; w.x = cvt_pk_bf16(gelu_tanh(v0[0]), gelu_tanh(v0[1])); w.y = cvt_pk_bf16(gelu_tanh(v0[2]), gelu_tanh(v0[3]));
                    w.z = cvt_pk_bf16(gelu_tanh(v1[0]), gelu_tanh(v1[1])); w.w = cvt_pk_bf16(gelu_tanh(v1[2]), gelu_tanh(v1[3]));
                    *(u32x4*)(Y + ((size_t)(chunk * 16 + t)) * 512 + gg * 16 + go0) = w; } }
    }
};
struct EpiGLU {
    const bf16_t* Y; bf16_t* Z; const float* bias;
    __device__ __forceinline__ void operator()(const f32x4 (&acc)[2][2][4][2], const Unit& u, int wr, int wc, int fr, int fq) const {
        const int row0 = u.pm * BM + wr * 64 + fr, col0 = u.pn * BM + wc * 32 + 8 * fq;
#pragma unroll
        for (int ai = 0; ai < 2; ++ai)
#pragma unroll
            for (int m = 0; m < 4; ++m) { const int r = row0 + ai * HALF + m * 16;
#pragma unroll
                for (int bj = 0; bj < 2; ++bj) { const int c = col0 + bj * HALF; const f32x4 v0 = acc[ai][bj][m][0], v1 = acc[ai][bj][m][1];
                    const u32x4 yu = *(const u32x4*)(Y + (size_t)r * 512 + c); float y[8]; unpack8(yu, y);
                    const f32x4 b0 = *(const f32x4*)(bias + c), b1 = *(const f32x4*)(bias + c + 4);
                    float o[8];
#pragma unroll
                    for (int i = 0; i < 4; ++i) { o[i] = y[i] * sigmoidf_(v0[i] + b0[i]); o[i + 4] = y[i + 4] * sigmoidf_(v1[i] + b1[i]); }
                    *(u32x4*)(Z + (size_t)r * D + 512 + c) = pack8(o); } }
    }
};
}

__device__ __forceinline__ void tr_item(const float* W, int N, bf16* WT, int ldt, LAS float* scr, int item, int lane) {
    const int nblk = N / 32, kb = item / nblk, nb = item % nblk, k0 = 64 * kb, n0 = 32 * nb;
    float tv[32];
#pragma unroll
    for (int i = 0; i < 32; ++i) tv[i] = W[(size_t)(k0 + 2 * i + (lane >> 5)) * N + n0 + (lane & 31)];
#pragma unroll
    for (int i = 0; i < 32; ++i) scr[(2 * i + (lane >> 5)) * 33 + (lane & 31)] = tv[i];
    asm volatile("s_waitcnt lgkmcnt(0)" ::: "memory");
    const int c = lane & 7;
#pragma unroll
    for (int j = 0; j < 4; ++j) { const int n = (lane >> 3) + 8 * j; const LAS float* s = scr + (8 * c) * 33 + n;
        u32x4 o; o.x = cvt_pk_bf16(s[0 * 33], s[1 * 33]); o.y = cvt_pk_bf16(s[2 * 33], s[3 * 33]); o.z = cvt_pk_bf16(s[4 * 33], s[5 * 33]); o.w = cvt_pk_bf16(s[6 * 33], s[7 * 33]);
        *(u32x4*)(WT + (size_t)(n0 + n) * ldt + k0 + 8 * c) = o; }
    asm volatile("s_waitcnt lgkmcnt(0)" ::: "memory");
}

__device__ __forceinline__ f32x2 cmul(f32x2 a, f32x2 b) { return (f32x2){a.x * b.x - a.y * b.y, a.x * b.y + a.y * b.x}; }
__device__ __forceinline__ f32x2 lam_pow(float lre, float lim, float st, int d) {
    const float mag = fast_exp(lre * st * (float)d);
    const double rev = (double)lim * (double)st * (double)d * 0.15915494309189535;
    const float fr = (float)(rev - __builtin_rint(rev));
    return (f32x2){mag * __builtin_amdgcn_cosf(fr), mag * __builtin_amdgcn_sinf(fr)};
}

__device__ __forceinline__ void rms_mod_rows(const float* xp, const float* xs_m, bf16* H, const float* gam, const float* modl, int sidx, int gw, int NGW, int lane) {
    for (int r = gw; r < NTOK; r += 2 * NGW) {
        const int r1 = r + NGW; const bool has1 = r1 < NTOK; const int r1c = has1 ? r1 : r;
        const float* xr0 = (r < NP ? xp : xs_m) + (size_t)r * D; const float* xr1 = (r1c < NP ? xp : xs_m) + (size_t)r1c * D;
        f32x4 v0[4], v1[4]; float s0 = 0.f, s1 = 0.f;
#pragma unroll
        for (int j = 0; j < 4; ++j) { v0[j] = *((const f32x4*)xr0 + lane + 64 * j); v1[j] = *((const f32x4*)xr1 + lane + 64 * j); }
#pragma unroll
        for (int j = 0; j < 4; ++j) { s0 += (v0[j].x * v0[j].x + v0[j].y * v0[j].y) + (v0[j].z * v0[j].z + v0[j].w * v0[j].w);
                                      s1 += (v1[j].x * v1[j].x + v1[j].y * v1[j].y) + (v1[j].z * v1[j].z + v1[j].w * v1[j].w); }
        const float rstd0 = 1.0f / sqrtf(wave_sum(s0) * (1.f / D) + EPS), rstd1 = 1.0f / sqrtf(wave_sum(s1) * (1.f / D) + EPS);
        const float* sh0 = modl + cond_of_row(r) * 6144 + sidx * 1024; const float* sh1 = modl + cond_of_row(r1c) * 6144 + sidx * 1024;
#pragma unroll
        for (int j = 0; j < 4; ++j) { const int c = 4 * (lane + 64 * j);
            const f32x4 g4 = *(const f32x4*)(gam + c);
            { const f32x4 s4 = *(const f32x4*)(sh0 + 1024 + c), h4 = *(const f32x4*)(sh0 + c); const f32x4 o = (v0[j] * rstd0) * g4 * (s4 + 1.0f) + h4;
              u32x2 w; w.x = cvt_pk_bf16(o.x, o.y); w.y = cvt_pk_bf16(o.z, o.w); *(u32x2*)(H + (size_t)r * D + c) = w; }
            if (has1) { const f32x4 s4 = *(const f32x4*)(sh1 + 1024 + c), h4 = *(const f32x4*)(sh1 + c); const f32x4 o = (v1[j] * rstd1) * g4 * (s4 + 1.0f) + h4;
              u32x2 w; w.x = cvt_pk_bf16(o.x, o.y); w.y = cvt_pk_bf16(o.z, o.w); *(u32x2*)(H + (size_t)r1 * D + c) = w; }
        }
    }
}

__device__ __forceinline__ void wait_vm(int n) {
    switch (n) {
        case 0: asm volatile("s_waitcnt vmcnt(0)" ::: "memory"); break;   case 1: asm volatile("s_waitcnt vmcnt(1)" ::: "memory"); break;
        case 2: asm volatile("s_waitcnt vmcnt(2)" ::: "memory"); break;   case 3: asm volatile("s_waitcnt vmcnt(3)" ::: "memory"); break;
        case 4: asm volatile("s_waitcnt vmcnt(4)" ::: "memory"); break;   case 5: asm volatile("s_waitcnt vmcnt(5)" ::: "memory"); break;
        case 6: asm volatile("s_waitcnt vmcnt(6)" ::: "memory"); break;   case 7: asm volatile("s_waitcnt vmcnt(7)" ::: "memory"); break;
        case 8: asm volatile("s_waitcnt vmcnt(8)" ::: "memory"); break;   case 9: asm volatile("s_waitcnt vmcnt(9)" ::: "memory"); break;
        case 10: asm volatile("s_waitcnt vmcnt(10)" ::: "memory"); break; case 11: asm volatile("s_waitcnt vmcnt(11)" ::: "memory"); break;
        case 12: asm volatile("s_waitcnt vmcnt(12)" ::: "memory"); break; case 13: asm volatile("s_waitcnt vmcnt(13)" ::: "memory"); break;
        case 14: asm volatile("s_waitcnt vmcnt(14)" ::: "memory"); break; default: asm volatile("s_waitcnt vmcnt(15)" ::: "memory"); break;
    }
}
__device__ __forceinline__ void dma16(const bf16* g, LAS unsigned char* l) { __builtin_amdgcn_global_load_lds((const unsigned*)g, (LAS unsigned*)l, 16, 0, 0); }
template <bool BIAS, int kpitchA, int rsA, int vpitchA>
__device__ __forceinline__ void attn_seg(const bf16x8 qf0, const bf16x8 qf1, const bf16* kA, const bf16* vtA, LAS unsigned char* wl,
                                         const LAS float* rpbh, int r, int r0, int s0, int cb, int lane, float& mout, float& sumout, f32x4 (&o)[4]) {
    const int l16 = lane & 15, g4 = lane >> 4;
    const LAS unsigned char* rl = wl + lane * 16;
    f32x4 s[16];
    constexpr int RK = 8;
    const bf16* kbase = kA + (size_t)((l16 >> 2) * 8 + (l16 & 3)) * kpitchA + g4 * 8;
    const bf16* kr = kbase;
#pragma unroll
    for (int t = 0; t < RK - 1; ++t) { dma16(kr, wl + t * 2048); dma16(kr + 32, wl + t * 2048 + 1024);
        kr += (size_t)((t & 1) ? (rsA - 4) : 4) * kpitchA; asm volatile("" : "+v"(kr)); }
#pragma unroll
    for (int t = 0; t < 16; ++t) {
        if (t + RK - 1 < 16) { const int tn = t + RK - 1;
            dma16(kr, wl + (tn % RK) * 2048); dma16(kr + 32, wl + (tn % RK) * 2048 + 1024);
            kr += (size_t)((tn & 1) ? (rsA - 4) : 4) * kpitchA; asm volatile("" : "+v"(kr)); }
        wait_vm(2 * ((15 - t) < (RK - 1) ? (15 - t) : (RK - 1)));
        const bf16x8 a0 = *(const LAS bf16x8*)(rl + (t % RK) * 2048), a1 = *(const LAS bf16x8*)(rl + (t % RK) * 2048 + 1024);
        f32x4 z = (f32x4){0.f, 0.f, 0.f, 0.f};
        z = __builtin_amdgcn_mfma_f32_16x16x32_bf16(a0, qf0, z, 0, 0, 0);
        s[t] = __builtin_amdgcn_mfma_f32_16x16x32_bf16(a1, qf1, z, 0, 0, 0);
        __builtin_amdgcn_sched_barrier(0);
    }
    constexpr int RV = 16;
    const bf16* vbase = vtA + (size_t)l16 * vpitchA + g4 * 8;
    asm volatile("s_waitcnt lgkmcnt(0)" ::: "memory");
    const bf16* vr = vbase;
#pragma unroll
    for (int q = 0; q < RV - 1; ++q) { dma16(vr, wl + q * 1024);
        vr += ((q & 3) == 3) ? (ptrdiff_t)rsA - (ptrdiff_t)48 * vpitchA : (ptrdiff_t)16 * vpitchA; asm volatile("" : "+v"(vr)); }
    __builtin_amdgcn_sched_barrier(0);
    float mx = -3.0e38f;
    constexpr float SC = 0.125f * 1.44269504089f, L2E = 1.44269504089f;
    if (BIAS) {
        int cidx[8];
        const int qc = cb * 16 + l16; int c0 = qc - 8; c0 = c0 < 0 ? 0 : (c0 > 48 ? 48 : c0);
#pragma unroll
        for (int e = 0; e < 8; ++e) { const int x = g4 * 8 + e, kc = s0 + x; int co = kc - qc; co = co < -15 ? -15 : (co > 15 ? 15 : co);
            cidx[e] = (kc >= c0 && kc < c0 + 16) ? (co + 15) : -1; }
#pragma unroll
        for (int t = 0; t < 16; ++t) { const int y = t >> 1; const LAS float* rp = rpbh + (r0 + y - r + 7) * 31;
#pragma unroll
            for (int i = 0; i < 4; ++i) { const int ci = cidx[(t & 1) * 4 + i];
                const float bsv = rp[ci >= 0 ? ci : 0];
                const float v = ci >= 0 ? s[t][i] * SC + bsv * L2E : -1.0e30f; s[t][i] = v; mx = fmaxf(mx, v); } }
    } else {
#pragma unroll
        for (int t = 0; t < 16; ++t)
#pragma unroll
            for (int i = 0; i < 4; ++i) { const float v = s[t][i] * SC; s[t][i] = v; mx = fmaxf(mx, v); }
    }
    mx = fmaxf(mx, __shfl_xor(mx, 16)); mx = fmaxf(mx, __shfl_xor(mx, 32));
    float sum = 0.f;
#pragma unroll
    for (int dt = 0; dt < 4; ++dt) o[dt] = (f32x4){0.f, 0.f, 0.f, 0.f};
#pragma unroll
    for (int j = 0; j < 8; ++j) {
        float p[8];
#pragma unroll
        for (int i = 0; i < 4; ++i) { p[i] = __builtin_amdgcn_exp2f(s[2 * j][i] - mx); p[4 + i] = __builtin_amdgcn_exp2f(s[2 * j + 1][i] - mx); }
#pragma unroll
        for (int i = 0; i < 8; ++i) sum += p[i];
        const bf16x8 pb = __builtin_bit_cast(bf16x8, pack8(p));
#pragma unroll
        for (int dt = 0; dt < 4; ++dt) {
            const int q = j * 4 + dt, qn = q + RV - 1;
            if (qn < 32) { dma16(vr, wl + (qn % RV) * 1024);
                vr += ((qn & 3) == 3) ? (ptrdiff_t)rsA - (ptrdiff_t)48 * vpitchA : (ptrdiff_t)16 * vpitchA; asm volatile("" : "+v"(vr)); }
            wait_vm((31 - q) < (RV - 1) ? (31 - q) : (RV - 1));
            const bf16x8 vq = *(const LAS bf16x8*)(rl + (q % RV) * 1024);
            o[dt] = __builtin_amdgcn_mfma_f32_16x16x32_bf16(vq, pb, o[dt], 0, 0, 0);
            __builtin_amdgcn_sched_barrier(0);
        }
    }
    asm volatile("s_waitcnt lgkmcnt(0)" ::: "memory");
    sum += __shfl_xor(sum, 16); sum += __shfl_xor(sum, 32);
    mout = mx; sumout = sum;
}
template <bool NA>
__device__ __forceinline__ void attn_unit(const bf16* qrow, const bf16* kA, const bf16* vtA,
                                          const bf16* kB, const bf16* vtB, const LAS float* rpbh, int r, int r0, int s0, int cb, bf16* orow, int lane, LAS unsigned char* wl) {
    const int g4 = lane >> 4;
    const bf16x8 qf0 = *(const bf16x8*)(qrow + g4 * 8), qf1 = *(const bf16x8*)(qrow + 32 + g4 * 8);
    f32x4 o[4]; float m, sum;
    if (NA) attn_seg<true, QP, 64, VSP>(qf0, qf1, kA, vtA, wl, rpbh, r, r0, s0, cb, lane, m, sum, o);
    else attn_seg<false, QP, 32, VPP>(qf0, qf1, kA, vtA, wl, rpbh, r, r0, s0, cb, lane, m, sum, o);
    if (NA) {
        f32x4 o2[4]; float m2, sum2;
        attn_seg<false, 64, 32, VPP>(qf0, qf1, kB, vtB, wl, (const LAS float*)nullptr, 0, 0, 0, 0, lane, m2, sum2, o2);
        const float mm = fmaxf(m, m2), wa = __builtin_amdgcn_exp2f(m - mm), wb = __builtin_amdgcn_exp2f(m2 - mm);
        sum = sum * wa + sum2 * wb;
#pragma unroll
        for (int dt = 0; dt < 4; ++dt) o[dt] = o[dt] * wa + o2[dt] * wb;
    }
    const float inv = 1.0f / sum;
#pragma unroll
    for (int dt = 0; dt < 4; ++dt) { u32x2 w; w.x = cvt_pk_bf16(o[dt][0] * inv, o[dt][1] * inv); w.y = cvt_pk_bf16(o[dt][2] * inv, o[dt][3] * inv);
        *(u32x2*)(orow + dt * 16 + g4 * 4) = w; }
}


__device__ __forceinline__ int kimg_f(int kidx) { return ((kidx >> 3) & 3) | (((kidx >> 1) & 1) << 2); }
__device__ __forceinline__ int kimg_off(int kidx, int c) { return kidx * 128 + ((c ^ kimg_f(kidx)) << 4); }
__device__ __forceinline__ void stage_k(LAS unsigned char* img, const bf16* g0, int pitch, int nkeys, int wave, int lane) {
    const int kin = lane >> 3, p = lane & 7;
    for (int pc = wave; pc < (nkeys >> 3); pc += NWAVES) { const int key = pc * 8 + kin, c = p ^ kimg_f(key);
        dma16(g0 + (size_t)key * pitch + c * 8, img + pc * 1024); }
}
__device__ __forceinline__ void stage_v(LAS unsigned char* img, const bf16* g0, int gpitch, int ntok, int VB, int wave, int lane) {
    const int total = 64 * VB;
    for (int pc = wave; pc * 1024 < total; pc += NWAVES) { const int o = pc * 1024 + lane * 16; int d = o / VB, w = o - d * VB;
        if (d > 63) { d = 63; w = 0; } if (w >= ntok * 2) w = 0;
        dma16(g0 + (size_t)d * gpitch + (w >> 1), img + pc * 1024); }
}
template <bool BIAS, int RS>
__device__ __forceinline__ float qk_lds(const bf16x8 qf0, const bf16x8 qf1, const LAS unsigned char* kimg, int kwin, f32x4 (&s)[16],
                                        const LAS float* rpbh, int r, int r0, int s0, int cb, int lane) {
    const int l16 = lane & 15, g4 = lane >> 4;
    const int xl = (l16 >> 2) * 8 + (l16 & 3);
#pragma unroll
    for (int t = 0; t < 16; ++t) {
        const int kidx = kwin + (t >> 1) * RS + (t & 1) * 4 + xl;
        const bf16x8 a0 = *(const LAS bf16x8*)(kimg + kimg_off(kidx, g4)), a1 = *(const LAS bf16x8*)(kimg + kimg_off(kidx, 4 + g4));
        f32x4 z = (f32x4){0.f, 0.f, 0.f, 0.f};
        z = __builtin_amdgcn_mfma_f32_16x16x32_bf16(a0, qf0, z, 0, 0, 0);
        s[t] = __builtin_amdgcn_mfma_f32_16x16x32_bf16(a1, qf1, z, 0, 0, 0);
    }
    float mx = -3.0e38f;
    constexpr float SC = 0.125f * 1.44269504089f, L2E = 1.44269504089f;
    if (BIAS) {
        int cidx[8];
        const int qc = cb * 16 + l16; int c0 = qc - 8; c0 = c0 < 0 ? 0 : (c0 > 48 ? 48 : c0);
#pragma unroll
        for (int e = 0; e < 8; ++e) { const int x = g4 * 8 + e, kc = s0 + x; int co = kc - qc; co = co < -15 ? -15 : (co > 15 ? 15 : co);
            cidx[e] = (kc >= c0 && kc < c0 + 16) ? (co + 15) : -1; }
#pragma unroll
        for (int t = 0; t < 16; ++t) { const int y = t >> 1; const LAS float* rp = rpbh + (r0 + y - r + 7) * 31;
#pragma unroll
            for (int i = 0; i < 4; ++i) { const int ci = cidx[(t & 1) * 4 + i];
                const float bsv = rp[ci >= 0 ? ci : 0];
                const float v = ci >= 0 ? s[t][i] * SC + bsv * L2E : -1.0e30f; s[t][i] = v; mx = fmaxf(mx, v); } }
    } else {
#pragma unroll
        for (int t = 0; t < 16; ++t)
#pragma unroll
            for (int i = 0; i < 4; ++i) { const float v = s[t][i] * SC; s[t][i] = v; mx = fmaxf(mx, v); }
    }
    mx = fmaxf(mx, __shfl_xor(mx, 16)); mx = fmaxf(mx, __shfl_xor(mx, 32));
    return mx;
}
template <int RS, int VB>
__device__ __forceinline__ float pv_lds(const LAS unsigned char* vimg, int kwin, const f32x4 (&s)[16], float mx, f32x4 (&o)[4], int lane) {
    const int l16 = lane & 15, g4 = lane >> 4;
    const LAS unsigned char* vb = vimg + l16 * VB + (kwin + g4 * 8) * 2;
    float sum = 0.f;
#pragma unroll
    for (int dt = 0; dt < 4; ++dt) o[dt] = (f32x4){0.f, 0.f, 0.f, 0.f};
#pragma unroll
    for (int j = 0; j < 8; ++j) {
        float p[8];
#pragma unroll
        for (int i = 0; i < 4; ++i) { p[i] = __builtin_amdgcn_exp2f(s[2 * j][i] - mx); p[4 + i] = __builtin_amdgcn_exp2f(s[2 * j + 1][i] - mx); }
#pragma unroll
        for (int i = 0; i < 8; ++i) sum += p[i];
        const bf16x8 pb = __builtin_bit_cast(bf16x8, pack8(p));
#pragma unroll
        for (int dt = 0; dt < 4; ++dt) {
            const bf16x8 vq = *(const LAS bf16x8*)(vb + dt * 16 * VB + j * RS * 2);
            o[dt] = __builtin_amdgcn_mfma_f32_16x16x32_bf16(vq, pb, o[dt], 0, 0, 0);
        }
    }
    sum += __shfl_xor(sum, 16); sum += __shfl_xor(sum, 32);
    return sum;
}
__device__ __forceinline__ void attn_store(bf16* orow, const f32x4 (&o)[4], float sum, int lane) {
    const int g4 = lane >> 4; const float inv = 1.0f / sum;
#pragma unroll
    for (int dt = 0; dt < 4; ++dt) { u32x2 w; w.x = cvt_pk_bf16(o[dt][0] * inv, o[dt][1] * inv); w.y = cvt_pk_bf16(o[dt][2] * inv, o[dt][3] * inv);
        *(u32x2*)(orow + dt * 16 + g4 * 4) = w; }
}
#define LDS_SYNC_ALL() do { asm volatile("s_waitcnt vmcnt(0) lgkmcnt(0)" ::: "memory"); __syncthreads(); } while (0)
__device__ __forceinline__ void ctx_block_unit(int id, const bf16* QKV, const bf16* VTP, bf16* Z, LAS unsigned char* lds, int wave, int lane) {
    const int bh = id >> 1, b = bh >> 3, hh = bh & 7, qt = (id & 1) * 8 + wave, l16 = lane & 15, g4 = lane >> 4;
    const int tq = b * 256 + qt * 16 + l16;
    const bf16* qrow = QKV + (size_t)tq * QP + hh * 64;
    const bf16x8 qf0 = *(const bf16x8*)(qrow + g4 * 8), qf1 = *(const bf16x8*)(qrow + 32 + g4 * 8);
    stage_k(lds, QKV + (size_t)(b * 256) * QP + 512 + hh * 64, QP, 256, wave, lane);
    stage_v(lds + 32768, VTP + (size_t)(bh * 64) * VPP, VPP, 256, 528, wave, lane);
    LDS_SYNC_ALL();
    f32x4 s[16], o[4];
    const float mx = qk_lds<false, 32>(qf0, qf1, lds, 0, s, (const LAS float*)nullptr, 0, 0, 0, 0, lane);
    const float sum = pv_lds<32, 528>(lds + 32768, 0, s, mx, o, lane);
    attn_store(Z + (size_t)tq * D + hh * 64, o, sum, lane);
    LDS_SYNC_ALL();
}
__device__ __forceinline__ void na_block_unit(int id, const bf16* QKV, const bf16* VTS, const bf16* KC, const bf16* VTC, const LAS float* rpb_l, bf16* Z, LAS unsigned char* lds, int wave, int lane) {
    const int bh = id >> 4, rp = id & 15, b = bh >> 3, hh = bh & 7, r = 2 * rp + (wave >> 2), cb = wave & 3, l16 = lane & 15, g4 = lane >> 4;
    int r0 = r - 4; r0 = r0 < 0 ? 0 : (r0 > 24 ? 24 : r0);
    int r0a = 2 * rp - 4; r0a = r0a < 0 ? 0 : (r0a > 24 ? 24 : r0a);
    int s0 = cb * 16 - 8; s0 = s0 < 0 ? 0 : (s0 > 32 ? 32 : s0);
    const int nrows = (32 - r0a) < 9 ? (32 - r0a) : 9;
    const int tb = NP + b * 2048, tq = tb + r * 64 + cb * 16 + l16;
    const bf16* qrow = QKV + (size_t)tq * QP + hh * 64;
    const bf16x8 qf0 = *(const bf16x8*)(qrow + g4 * 8), qf1 = *(const bf16x8*)(qrow + 32 + g4 * 8);
    const int kwin = (r0 - r0a) * 64 + s0;
    stage_k(lds, QKV + (size_t)(tb + r0a * 64) * QP + 512 + hh * 64, QP, nrows * 64, wave, lane);
    LDS_SYNC_ALL();
    f32x4 s[16], o[4];
    const float m1 = qk_lds<true, 64>(qf0, qf1, lds, kwin, s, rpb_l + hh * 465, r, r0, s0, cb, lane);
    LDS_SYNC_ALL();
    LAS unsigned char* kc_img = lds + 74752;
    stage_v(lds, VTS + (size_t)(bh * 64) * VSP + r0a * 64, VSP, nrows * 64, 1168, wave, lane);
    stage_k(kc_img, KC + (size_t)bh * 256 * 64, 64, 256, wave, lane);
    LDS_SYNC_ALL();
    float sum = pv_lds<64, 1168>(lds, kwin, s, m1, o, lane);
    LDS_SYNC_ALL();
    stage_v(lds, VTC + (size_t)bh * 64 * VPP, VPP, 256, 528, wave, lane);
    f32x4 o2[4];
    const float m2 = qk_lds<false, 32>(qf0, qf1, kc_img, 0, s, (const LAS float*)nullptr, 0, 0, 0, 0, lane);
    LDS_SYNC_ALL();
    const float sum2 = pv_lds<32, 528>(lds, 0, s, m2, o2, lane);
    const float mm = fmaxf(m1, m2), wa = __builtin_amdgcn_exp2f(m1 - mm), wb = __builtin_amdgcn_exp2f(m2 - mm);
    sum = sum * wa + sum2 * wb;
#pragma unroll
    for (int dt = 0; dt < 4; ++dt) o[dt] = o[dt] * wa + o2[dt] * wb;
    attn_store(Z + (size_t)tq * D + hh * 64, o, sum, lane);
    LDS_SYNC_ALL();
}

__device__ __forceinline__ const float* ldp(const unsigned long long* tab, int k) {
    const unsigned long long v = __hip_atomic_load(tab + k, __ATOMIC_RELAXED, __HIP_MEMORY_SCOPE_WORKGROUP);
    const unsigned lo = __builtin_amdgcn_readfirstlane((unsigned)v), hi = __builtin_amdgcn_readfirstlane((unsigned)(v >> 32));
    return (const float*)(((unsigned long long)hi << 32) | lo);
}

#define XB_TMO      128
#define XB_XCNT(j)  (256  + 64 * (j))
#define XB_XSUB(j)  (1280 + 64 * (j))
#define XB_XGEN(j)  (2304 + 64 * (j))
#define XB_TOP      3328
#define XB_TOPGEN   3392
#define XCD_BAR_WORDS 3456
#define XB_SPIN_CAP (1u << 18)
__device__ __forceinline__ unsigned xb_ld(unsigned* p)              { return __hip_atomic_load(p, __ATOMIC_RELAXED, __HIP_MEMORY_SCOPE_AGENT); }
__device__ __forceinline__ unsigned xb_add(unsigned* p, unsigned v) { return __hip_atomic_fetch_add(p, v, __ATOMIC_RELAXED, __HIP_MEMORY_SCOPE_AGENT); }
__device__ __forceinline__ unsigned xb_xcc_id() { return (unsigned)__builtin_amdgcn_s_getreg((3 << 11) | 20) & 0xFu; }
#define XB_SPIN(cond, bar) do { unsigned _sp = 0; while (cond) { __builtin_amdgcn_s_sleep(1); \
    if ((++_sp & 255u) == 0u) { if (xb_ld(&(bar)[XB_TMO])) break; if (_sp > XB_SPIN_CAP) { atomicAdd(&(bar)[XB_TMO], 1u); break; } } } } while (0)
struct XcdBarrier { unsigned* bar; unsigned x; volatile LAS unsigned* st; };
__device__ __forceinline__ XcdBarrier xcd_barrier_post(unsigned* bar, volatile LAS unsigned* st) {
    XcdBarrier b; b.bar = bar; b.x = xb_xcc_id(); b.st = st;
    if (threadIdx.x == 0) (void)xb_add(&bar[XB_XCNT(b.x)], 1u);
    return b;
}
__device__ __forceinline__ void xcd_barrier_complete(unsigned* bar, unsigned x, unsigned& nloc, unsigned& nx) {
    const unsigned G = gridDim.x * gridDim.y * gridDim.z;
    unsigned sum, cnt, mine, sp = 0u;
    for (;;) {
        sum = 0u; cnt = 0u; mine = 0u;
#pragma unroll
        for (unsigned j = 0; j < 16; ++j) { const unsigned c = xb_ld(&bar[XB_XCNT(j)]); sum += c; cnt += (c > 0u) ? 1u : 0u; mine = (j == x) ? c : mine; }
        if (sum == G) break;
        __builtin_amdgcn_s_sleep(1);
        if ((++sp & 255u) == 0u) { if (xb_ld(&bar[XB_TMO])) break; if (sp > XB_SPIN_CAP) { atomicAdd(&bar[XB_TMO], 1u); break; } }
    }
    nloc = mine > 0u ? mine : 1u; nx = cnt > 0u ? cnt : 1u;
}
__device__ __forceinline__ void xcd_barrier(const XcdBarrier& b) {
    asm volatile("s_waitcnt vmcnt(0)" ::: "memory");
    __syncthreads();
    if (threadIdx.x == 0) {
        unsigned* bar = b.bar;
        __builtin_amdgcn_s_waitcnt(0);
        unsigned nloc = b.st[0], nx = b.st[1];
        if (nloc == 0u) { xcd_barrier_complete(bar, b.x, nloc, nx); b.st[0] = nloc; b.st[1] = nx; }
        const unsigned old = xb_add(&bar[XB_XSUB(b.x)], 1u);
        const unsigned gen = old / nloc;
        if (old + 1u == (gen + 1u) * nloc) {
            __builtin_amdgcn_fence(__ATOMIC_RELEASE, "agent");
            asm volatile("s_waitcnt vmcnt(0)" ::: "memory");
            const unsigned og = xb_add(&bar[XB_TOP], 1u);
            const unsigned tg = og / nx;
            if (og + 1u == (tg + 1u) * nx) xb_add(&bar[XB_TOPGEN], 1u);
            else XB_SPIN(xb_ld(&bar[XB_TOPGEN]) == tg, bar);
            __builtin_amdgcn_fence(__ATOMIC_ACQUIRE, "agent");
            xb_add(&bar[XB_XGEN(b.x)], 1u);
            asm volatile("s_waitcnt vmcnt(0)" ::: "memory");
        } else {
            XB_SPIN(xb_ld(&bar[XB_XGEN(b.x)]) == gen, bar);
            __builtin_amdgcn_fence(__ATOMIC_ACQUIRE, "agent");
            asm volatile("s_waitcnt vmcnt(0)" ::: "memory");
        }
    }
    __syncthreads();
}
struct Args { const float* in[33]; float* out; unsigned char* ws; int ph_lo, ph_hi; };

__global__ void __launch_bounds__(NTHR) fwd_megakernel(Args args) {
    extern __shared__ __attribute__((aligned(16))) unsigned char lds_raw[];
    LAS unsigned char* lds = (LAS unsigned char*)lds_raw;
    cg::grid_group grid = cg::this_grid();
    const int wave = __builtin_amdgcn_readfirstlane((int)threadIdx.x >> 6);
    const int G = gridDim.x, bx = blockIdx.x;
    const int vcu = (G % 8 == 0) ? (bx % 8) * (G / 8) + bx / 8 : bx;
    const int gw = vcu * NWAVES + wave, NGW = G * NWAVES;
    const int NGT = G * NTHR;
#define PHASE_IDS const int lane = lane_id(), tid = wave * 64 + lane, gtid = vcu * NTHR + tid; (void)gtid; (void)tid;
    unsigned char* ws = args.ws;
    float* out = args.out;
    unsigned long long* tab = (unsigned long long*)(ws + WS_TAB) + (size_t)blockIdx.x * 64;
    if (threadIdx.x == 0) {
#pragma unroll
        for (int k = 0; k < 33; ++k) tab[k] = (unsigned long long)args.in[k];
    }
    { const float* rp_ = args.in[20]; LAS float* rl_ = (LAS float*)(lds + LDS_RPB); for (int i = threadIdx.x; i < 8 * 465; i += NTHR) rl_[i] = rp_[i]; }
    volatile LAS unsigned* bst = (volatile LAS unsigned*)(lds + 131072);
    if (threadIdx.x < 8) bst[threadIdx.x] = 0u;
    asm volatile("s_waitcnt vmcnt(0) lgkmcnt(0)" ::: "memory");
    __syncthreads();
    XcdBarrier xbar; xbar.bar = (unsigned*)(ws + WS_BAR); xbar.x = 0; xbar.st = bst;
    if (args.ph_hi - args.ph_lo > 1) xbar = xcd_barrier_post((unsigned*)(ws + WS_BAR), bst);
    if (args.ph_hi > 1000) grid.sync();
    float* MODS = (float*)(ws + WS_MODS); f32x2* LPOW = (f32x2*)(ws + WS_LPOW); f32x2* BBAR = (f32x2*)(ws + WS_BBAR); float* KTAB = (float*)(ws + WS_KTAB);
    bf16* KC = (bf16*)(ws + WS_KC); bf16* VTC = (bf16*)(ws + WS_VTC);
    bf16* WIN0 = (bf16*)(ws + WS_WIN0); bf16* WOUT0 = (bf16*)(ws + WS_WOUT0); bf16* W1_0 = (bf16*)(ws + WS_W1_0); bf16* W2_0 = (bf16*)(ws + WS_W2_0);
    bf16* WIN1 = (bf16*)(ws + WS_WIN1); bf16* WOUT1 = (bf16*)(ws + WS_WOUT1); bf16* W1_1 = (bf16*)(ws + WS_W1_1); bf16* W2_1 = (bf16*)(ws + WS_W2_1);
    bf16* GLUT = (bf16*)(ws + WS_GLUT); bf16* BMAT = (bf16*)(ws + WS_BMAT); bf16* FMAT = (bf16*)(ws + WS_FMAT);
    bf16* H = (bf16*)(ws + WS_H); float* FBUF = (float*)(ws + WS_H);
    bf16* HID = (bf16*)(ws + WS_R); bf16* PROJ0 = (bf16*)(ws + WS_R); bf16* QKV = (bf16*)(ws + WS_R);
    bf16* Z = (bf16*)(ws + WS_Z); bf16* ABUF = (bf16*)(ws + WS_ABUF); bf16* YBUF = (bf16*)(ws + WS_YBUF);
    bf16* VTP = (bf16*)(ws + WS_VTP); bf16* VTS = (bf16*)(ws + WS_VTS);
    float* XBUF = (float*)(ws + WS_XBUF); unsigned* PCNT = (unsigned*)(ws + WS_BAR) + CNT_OFF_WORDS;
    float* X = out;

    const int lo = args.ph_lo, hi = args.ph_hi;
#ifndef PHMASK
#define PHMASK 0x7ffff
#endif
#define IN(k) (((PHMASK >> (k)) & 1) && lo <= (k) && (k) < hi)
#ifndef REPMASK
#define REPMASK 0
#endif
#define REP(k) for (int rep_ = 0; rep_ < (((REPMASK >> (k)) & 1) + 1); ++rep_)
#define SEAM2(k, k2) do { if (IN(k) && IN(k2)) xcd_barrier(xbar); } while (0)
#define SEAM(k) do { if (IN(k) && IN((k) + 1)) xcd_barrier(xbar); } while (0)

    if (IN(0)) REP(0) { PHASE_IDS
        const float* ab_w_in = ldp(tab, 14);
        const float* ab_w_out = ldp(tab, 18);
        const float* mlp_w1 = ldp(tab, 12);
        const float* mlp_w2 = ldp(tab, 13);
        LAS float* scr = (LAS float*)(lds + wave * 16384);
        constexpr int I0 = 1024, I1 = I0 + 256, I2 = I1 + 2048, I3 = I2 + 2048;
        for (int it = gw; it < I3; it += NGW) {
            if (it < I0) tr_item(ab_w_in, 2048, WIN0, 1024, scr, it, lane);
            else if (it < I1) tr_item(ab_w_out + (size_t)512 * 1024, 1024, WOUT0 + 512, 1024, scr, it - I0, lane);
            else if (it < I2) tr_item(mlp_w1, 4096, W1_0, 1024, scr, it - I1, lane);
            else tr_item(mlp_w2, 1024, W2_0, 4096, scr, it - I2, lane);
        }
        __syncthreads();
        {
            const float* ada_w = ldp(tab, 10); const float* ada_b = ldp(tab, 11); const float* cvec = ldp(tab, 2); const float* c_ctx = ldp(tab, 7);
            LAS float* sl = (LAS float*)lds;
            LAS float* red = (LAS float*)(lds + 32768);
            if (vcu < 192) {
                for (int i = tid; i < 5 * 1024; i += NTHR) { const float c = i < 4096 ? cvec[i] : c_ctx[i - 4096]; sl[i] = c * sigmoidf_(c); }
                __syncthreads();
                for (int it = vcu; it < 192; it += G) {
                    const int layer = it / 96, n = (it % 96) * 64 + (tid & 63), kc = tid >> 6;
                    const float* w = ada_w + (size_t)layer * 1024 * 6144 + (size_t)(kc * 128) * 6144 + n;
                    float a0 = 0.f, a1 = 0.f, a2 = 0.f, a3 = 0.f, a4 = 0.f;
#pragma unroll 32
                    for (int k = 0; k < 128; ++k) {
                        const int kk = kc * 128 + k; const float wv = w[(size_t)k * 6144];
                        a0 += sl[kk] * wv; a1 += sl[1024 + kk] * wv; a2 += sl[2048 + kk] * wv; a3 += sl[3072 + kk] * wv; a4 += sl[4096 + kk] * wv;
                    }
                    red[(kc * 5 + 0) * 64 + (tid & 63)] = a0; red[(kc * 5 + 1) * 64 + (tid & 63)] = a1; red[(kc * 5 + 2) * 64 + (tid & 63)] = a2;
                    red[(kc * 5 + 3) * 64 + (tid & 63)] = a3; red[(kc * 5 + 4) * 64 + (tid & 63)] = a4;
                    __syncthreads();
                    if (tid < 320) { const int cnd = tid >> 6, col = tid & 63; float s = 0.f;
#pragma unroll
                        for (int q = 0; q < 8; ++q) s += red[(q * 5 + cnd) * 64 + col];
                        const int nn = (it % 96) * 64 + col;
                        MODS[(layer * 5 + cnd) * 6144 + nn] = s + ada_b[layer * 6144 + nn]; }
                    __syncthreads();
                }
            }
        }
        {
            const float* log_step = ldp(tab, 23); const float* lam_re = ldp(tab, 21); const float* lam_im = ldp(tab, 22);
            const float* ssm_b_re = ldp(tab, 24); const float* ssm_b_im = ldp(tab, 25);
            for (int i = gtid; i < 2 * 32 * 17 * 64; i += NGT) {
                const int p = i & 63, d = (i >> 6) % 17, dg = i / (64 * 17);
                const float st = fast_exp(log_step[dg]);
                LPOW[i] = lam_pow(lam_re[dg * 64 + p], lam_im[dg * 64 + p], st, d);
            }
            for (int i = gtid; i < 2 * 32 * 64 * 16; i += NGT) {
                const int dgp = i >> 4, dg = dgp >> 6;
                const float st = fast_exp(log_step[dg]);
                const f32x2 lam = (f32x2){lam_re[dgp], lam_im[dgp]};
                const f32x2 z = lam * st;
                f32x2 phi;
                if (z.x * z.x + z.y * z.y < 0.25f) {
                    f32x2 acc = (f32x2){1.f, 0.f};
#pragma unroll
                    for (int n = 12; n >= 2; --n) { acc = cmul(acc, z) * (1.0f / (float)n); acc.x += 1.0f; }
                    phi = acc * st;
                } else {
                    const f32x2 L = lam_pow(lam.x, lam.y, st, 1);
                    const f32x2 num = (f32x2){L.x - 1.0f, L.y}; const float den = 1.0f / (lam.x * lam.x + lam.y * lam.y);
                    phi = (f32x2){(num.x * lam.x + num.y * lam.y) * den, (num.y * lam.x - num.x * lam.y) * den};
                }
                BBAR[i] = cmul(phi, (f32x2){ssm_b_re[i], ssm_b_im[i]});
            }
        }
        {
            const float* cache_k = ldp(tab, 3); const float* cache_v = ldp(tab, 4);
            for (int i = gtid; i < 4 * 8 * 256 * 64 / 2; i += NGT) { const f32x2 v = *(const f32x2*)(cache_k + 2 * (size_t)i); ((unsigned*)KC)[i] = cvt_pk_bf16(v.x, v.y); }
            for (int i = gtid; i < 4 * 8 * 64 * 256 / 2; i += NGT) { const int l2 = i & 127, d = (i >> 7) & 63, bh = i >> 13;
                const float a = cache_v[((size_t)bh * 256 + 2 * l2) * 64 + d], b = cache_v[((size_t)bh * 256 + 2 * l2 + 1) * 64 + d];
                *(unsigned*)(VTC + ((size_t)(bh * 64 + d)) * VPP + 2 * l2) = cvt_pk_bf16(a, b); }
        }
        {
            const float* pool_w = ldp(tab, 15); const float* pool_scale = ldp(tab, 16);
            for (int i = gtid; i < 128 * 1024; i += NGT) { const int n = i & 1023, k0 = (i >> 10) * 4, gq = k0 >> 7, c = k0 & 127;
                const float* pw = pool_w + ((size_t)gq * 128 + c) * 128; const float* ps = pool_scale + gq * 128; const float* wo = ab_w_out + (size_t)(gq * 128) * 1024 + n;
                float a0 = 0.f, a1 = 0.f, a2 = 0.f, a3 = 0.f;
#pragma unroll 32
                for (int d = 0; d < 128; ++d) { const float wv = ps[d] * wo[(size_t)d * 1024]; a0 += pw[d] * wv; a1 += pw[128 + d] * wv; a2 += pw[256 + d] * wv; a3 += pw[384 + d] * wv; }
                u32x2 w; w.x = cvt_pk_bf16(a0, a1); w.y = cvt_pk_bf16(a2, a3);
                *(u32x2*)(WOUT0 + (size_t)n * 1024 + k0) = w; }
        }
    }
    SEAM(0);

    if (IN(1)) REP(1) { PHASE_IDS
        const float* x_prompt = ldp(tab, 0);
        const float* x_sample = ldp(tab, 1);
        const float* norm1_g = ldp(tab, 8);
        rms_mod_rows(x_prompt, x_sample - (size_t)NP * D, H, norm1_g, MODS, 0, gw, NGW, lane);
    }
    SEAM(1);

    if (IN(2)) REP(2) {
        pg8::Gemm g{H, WIN0, 1024, 1024, 1024}; pg8::Sched S; S.init(48, 8, G, bx, 0);
        pg8::EpiStore<0> E{PROJ0, 2048};
        pg8::gemm_phase(lds, wave, g, S, E);
        if (bx >= 128) {
            const float* ssm_c_re = ldp(tab, 26); const float* ssm_c_im = ldp(tab, 27);
            const int sid = (bx - 128) * NTHR + wave * 64 + lane_id();
            if (sid < 64 * 256) {
                const int gi = sid & 15, go = (sid >> 4) & 15, dg = sid >> 8;
                const float* cr = ssm_c_re + ((size_t)dg * 16 + go) * 64; const float* ci = ssm_c_im + ((size_t)dg * 16 + go) * 64;
                const f32x2* lp = LPOW + ((size_t)dg * 17 + 1) * 64; const f32x2* bb = BBAR + (size_t)dg * 64 * 16 + gi;
                float a[16];
#pragma unroll
                for (int d = 0; d < 16; ++d) a[d] = 0.f;
#pragma unroll 2
                for (int p = 0; p < 64; ++p) { f32x2 v = cmul((f32x2){cr[p], ci[p]}, bb[p * 16]); const f32x2 L = lp[p];
#pragma unroll
                    for (int d = 0; d < 16; ++d) { a[d] += v.x; v = cmul(v, L); } }
#pragma unroll
                for (int d = 0; d < 16; ++d) KTAB[(((size_t)dg * 16 + d) * 16 + go) * 16 + gi] = a[d];
            }
        }
    }
    SEAM(2);

    if (IN(3)) REP(3) { PHASE_IDS
        const float* conv_w = ldp(tab, 17);

        for (int it = gtid; it < NTOK * 128; it += NGT) {
            int r, cv;
            if (it < NTOK * 64) { const int gq = it / (NTOK * 16), rem = it - gq * (NTOK * 16); r = rem >> 4; cv = gq * 16 + (rem & 15); }
            else { const int i2 = it - NTOK * 64; r = i2 >> 6; cv = 64 + (i2 & 63); }
            int sb, T, t;
            if (r < NP) { sb = r & ~255; T = 256; t = r & 255; } else { const int rs = r - NP; sb = NP + (rs & ~2047); T = 2048; t = rs & 2047; }
            float o[8];
            if (cv < 64) {
                const int gq = cv >> 4, hw = 1 << gq; const int l0 = t - hw < 0 ? 0 : t - hw, h1 = t + hw > T ? T : t + hw;
                float a[8];
#pragma unroll
                for (int q = 0; q < 8; ++q) a[q] = 0.f;
                const bf16* pb = PROJ0 + (size_t)sb * 2048 + cv * 8;
#define POOL_WIN(HW) { u32x4 w_[2 * HW]; _Pragma("unroll") for (int k = 0; k < 2 * HW; ++k) { int tt = t - HW + k; const bool ok = tt >= l0 && tt < h1; tt = ok ? tt : t; w_[k] = *(const u32x4*)(pb + (size_t)tt * 2048); if (!ok) w_[k] = (u32x4){0u, 0u, 0u, 0u}; } \
                    _Pragma("unroll") for (int k = 0; k < 2 * HW; ++k) { float f[8]; unpack8(w_[k], f); _Pragma("unroll") for (int q = 0; q < 8; ++q) a[q] += f[q]; } }
                if (gq == 0) POOL_WIN(1) else if (gq == 1) POOL_WIN(2) else if (gq == 2) POOL_WIN(4) else POOL_WIN(8)
#undef POOL_WIN
                float sf[8]; unpack8(*(const u32x4*)(pb + (size_t)t * 2048), sf);
                const float ic = 1.0f / (float)(h1 - l0);
#pragma unroll
                for (int q = 0; q < 8; ++q) o[q] = a[q] * ic - sf[q];
                *(u32x4*)(Z + (size_t)r * D + cv * 8) = pack8(o);
            } else {
                const int ch0 = (cv - 64) * 8;
                float bg[8]; unpack8(*(const u32x4*)(PROJ0 + (size_t)r * 2048 + 512 + ch0), bg);
#pragma unroll
                for (int q = 0; q < 8; ++q) o[q] = 0.f;
#pragma unroll
                for (int j = 0; j < 3; ++j) { const int tt = t + j - 1;
                    if (tt >= 0 && tt < T) { float cg8[8], vv[8]; const bf16* pr = PROJ0 + (size_t)(sb + tt) * 2048 + ch0;
                        unpack8(*(const u32x4*)(pr + 1024), cg8); unpack8(*(const u32x4*)(pr + 1536), vv);
                        const f32x4 w0 = *(const f32x4*)(conv_w + j * 512 + ch0), w1 = *(const f32x4*)(conv_w + j * 512 + ch0 + 4);
#pragma unroll
                        for (int q = 0; q < 4; ++q) { o[q] += w0[q] * cg8[q] * vv[q]; o[q + 4] += w1[q] * cg8[q + 4] * vv[q + 4]; } } }
#pragma unroll
                for (int q = 0; q < 8; ++q) o[q] *= bg[q];
                *(u32x4*)(Z + (size_t)r * D + 512 + ch0) = pack8(o);
            }
        }
    }
    SEAM(3);

    if (IN(4)) REP(4) {
        const float* x_prompt = ldp(tab, 0);
        const float* x_sample = ldp(tab, 1);

        pg8::Gemm g{Z, WOUT0, 1024, 1024, 1024}; pg8::Sched S; S.init(48, 4, G, bx, 3);
        pg8::EpiResGateNorm E{x_prompt, x_sample, X, MODS + 2 * 1024, ldp(tab, 9), MODS, 3, H, XBUF, PCNT + 0 * 48 * 64, lds + LDS_XOFF};
        pg8::gemm_phase(lds, wave, g, S, E);
    }
    SEAM2(4, 6);
    if (IN(6)) REP(6) {
        pg8::Gemm g{H, W1_0, 1024, 1024, 1024}; pg8::Sched S; S.init(48, 16, G, bx, 0);
        pg8::EpiStore<1> E{HID, 4096};
        pg8::gemm_phase(lds, wave, g, S, E);
    }
    SEAM(6);
    if (IN(7)) REP(7) {
        pg8::Gemm g{HID, W2_0, 4096, 4096, 4096}; pg8::Sched S; S.init(48, 4, G, bx, 3);
        pg8::EpiResGateNorm E{nullptr, nullptr, X, MODS + 5 * 1024, ldp(tab, 8) + 1024, MODS + 5 * 6144, 0, H, XBUF + (size_t)1 * NTOK * 4, PCNT + 1 * 48 * 64, lds + LDS_XOFF};
        pg8::gemm_phase(lds, wave, g, S, E);
        if (bx >= 192) {
            const float* mlp_w1 = ldp(tab, 12); const float* mlp_w2 = ldp(tab, 13); const float* cd_w_in = ldp(tab, 19); const float* cd_w_out = ldp(tab, 31); const float* glu_w = ldp(tab, 29);
            LAS float* scr = (LAS float*)(lds + wave * 16384); const int lane = lane_id();
            constexpr int J0 = 1024, J1 = J0 + 512, J2 = J1 + 128;
            for (int it = (bx - 192) * NWAVES + wave; it < J2; it += 64 * NWAVES) {
                if (it < J0) tr_item(cd_w_in, 2048, WIN1, 1024, scr, it, lane);
                else if (it < J1) tr_item(cd_w_out, 1024, WOUT1, 1024, scr, it - J0, lane);
                else tr_item(glu_w, 512, GLUT, 512, scr, it - J1, lane);
            }
            const float* ssm_c_re = ldp(tab, 26); const float* ssm_c_im = ldp(tab, 27); const float* ssm_d = ldp(tab, 28);
            const int sid = (bx - 192) * NTHR + wave * 64 + lane;
#pragma unroll 4
            for (int i = sid; i < 32 * 256 * 128; i += 64 * NTHR) {
                const int k = (i & 127) * 2, n = (i >> 7) & 255, gg = i >> 15, j = k >> 4, gi = k & 15, dir = n >> 7, p = (n & 127) >> 1, ri = n & 1;
                const int dg = dir * 32 + gg, e = dir == 0 ? 15 - j : j;
                const f32x2 L = LPOW[((size_t)dg * 17 + e) * 64 + p];
                const f32x2 v0 = cmul(L, BBAR[((size_t)dg * 64 + p) * 16 + gi]), v1 = cmul(L, BBAR[((size_t)dg * 64 + p) * 16 + gi + 1]);
                *(unsigned*)(FMAT + ((size_t)gg * 256 + n) * 512 + k) = cvt_pk_bf16(ri ? v0.y : v0.x, ri ? v1.y : v1.x);
            }
#pragma unroll 4
            for (int i = sid; i < 32 * 256 * 128; i += 64 * NTHR) {
                const int kk = (i & 127) * 2, n = (i >> 7) & 255, gg = i >> 15, t = n >> 4, go = n & 15, dir = kk >> 7, p = (kk & 127) >> 1;
                const int dg = dir * 32 + gg, e = dir == 0 ? t + 1 : 16 - t;
                const size_t ci = ((size_t)dg * 16 + go) * 64 + p;
                const f32x2 v = cmul((f32x2){ssm_c_re[ci], ssm_c_im[ci]}, LPOW[((size_t)dg * 17 + e) * 64 + p]);
                *(unsigned*)(BMAT + ((size_t)gg * 256 + n) * 512 + 256 + kk) = cvt_pk_bf16(v.x, -v.y);
            }
#pragma unroll 4
            for (int i = sid; i < 32 * 256 * 128; i += 64 * NTHR) {
                const int k = (i & 127) * 2, n = (i >> 7) & 255, gg = i >> 15, j = k >> 4, gi = k & 15, t = n >> 4, go = n & 15;
                float v0 = 0.f, v1 = 0.f;
                if (t >= j) { const float* kt = KTAB + (((size_t)(0 * 32 + gg) * 16 + (t - j)) * 16 + go) * 16 + gi; v0 += kt[0]; v1 += kt[1]; }
                if (j >= t) { const float* kt = KTAB + (((size_t)(1 * 32 + gg) * 16 + (j - t)) * 16 + go) * 16 + gi; v0 += kt[0]; v1 += kt[1]; }
                if (j == t) { const float dd = ssm_d[gg * 16 + go]; if (go == gi) v0 += dd; if (go == gi + 1) v1 += dd; }
                *(unsigned*)(BMAT + ((size_t)gg * 256 + n) * 512 + k) = cvt_pk_bf16(v0, v1);
            }
        }
    }
    SEAM2(7, 9);
    if (IN(9)) REP(9) {
        { pg8::Gemm g{H, WIN1, 1024, 1024, 1024}; pg8::Sched S; S.init(48, 6, G, bx, 1);
          pg8::EpiProj1 E{QKV, ABUF, out + O_K};
          pg8::gemm_phase(lds, wave, g, S, E); }
        { pg8::Gemm g{WIN1 + (size_t)1024 * 1024, H, 1024, 1024, 1024}; pg8::Sched S; S.init(2, 48, G, (bx + G - 32) % G, 0);
          pg8::EpiVT E{VTP, VTS, out + O_V};
          pg8::gemm_phase(lds, wave, g, S, E); }
        if (bx >= 128) {
            const float* mlp_w1 = ldp(tab, 12); const float* mlp_w2 = ldp(tab, 13);
            LAS float* scr = (LAS float*)(lds + wave * 16384); const int lane = lane_id();
            for (int it = (bx - 128) * NWAVES + wave; it < 4096; it += 128 * NWAVES) {
                if (it < 2048) tr_item(mlp_w1 + (size_t)1024 * 4096, 4096, W1_1, 1024, scr, it, lane);
                else tr_item(mlp_w2 + (size_t)4096 * 1024, 1024, W2_1, 4096, scr, it - 2048, lane);
            }
        }
    }
    SEAM2(9, 12);

#define ATTN_QUEUE(pi, jb, jn) do { \
    const int xq_ = (int)(xb_xcc_id() & 7u); unsigned* ctr_ = QCTR + ((pi) * 8 + xq_) * 16; \
    volatile LAS unsigned* qw_ = (volatile LAS unsigned*)(lds + 131072 + 64); \
    for (;;) { \
        __syncthreads(); \
        if (threadIdx.x == 0) qw_[0] = __hip_atomic_fetch_add(ctr_, 8u, __ATOMIC_RELAXED, __HIP_MEMORY_SCOPE_AGENT); \
        __syncthreads(); \
        const int f_ = (int)qw_[0]; \
        if (f_ >= (jn)) break; \
        const int j_ = (jb) + f_ + wave; \
        if (f_ + wave < (jn)) { \
        const int id = j_ < 256 ? xq_ * 256 + j_ : 2048 + xq_ * 512 + (j_ - 256); \
        const int ll = lane_id(); \
        const int l16 = ll & 15; \
        if (id < 2048) { \
            const int bh = id >> 4, qt = id & 15, b = bh >> 3, hh = bh & 7; \
            const int tq = b * 256 + qt * 16 + l16; \
            attn_unit<false>(QKV + (size_t)tq * QP + hh * 64, QKV + (size_t)(b * 256) * QP + 512 + hh * 64, VTP + (size_t)(bh * 64) * VPP, \
                             nullptr, nullptr, (const LAS float*)nullptr, 0, 0, 0, 0, Z + (size_t)tq * D + hh * 64, ll, lds + wave * 16384); \
        } else { \
            const int i2 = id - 2048, cb = i2 & 3, r = (i2 >> 2) & 31, bh = i2 >> 7, b = bh >> 3, hh = bh & 7; \
            int r0 = r - 4; r0 = r0 < 0 ? 0 : (r0 > 24 ? 24 : r0); \
            int s0 = cb * 16 - 8; s0 = s0 < 0 ? 0 : (s0 > 32 ? 32 : s0); \
            const int tb = NP + b * 2048, tq = tb + r * 64 + cb * 16 + l16; \
            attn_unit<true>(QKV + (size_t)tq * QP + hh * 64, QKV + (size_t)(tb + r0 * 64 + s0) * QP + 512 + hh * 64, \
                            VTS + (size_t)(bh * 64) * VSP + r0 * 64 + s0, KC + (size_t)bh * 256 * 64, VTC + (size_t)bh * 64 * VPP, \
                            rpb_l + hh * 465, r, r0, s0, cb, Z + (size_t)tq * D + hh * 64, ll, lds + wave * 16384); \
        } } \
    } } while (0)
    constexpr int AQ0 = 368, AQ1 = 184, AQ2 = 768 - AQ0 - AQ1;
    unsigned* QCTR = (unsigned*)(ws + WS_BAR) + 3584;
    const LAS float* rpb_l = (const LAS float*)(lds + LDS_RPB);
    if (IN(12)) REP(12) {
        { int kf = 256; asm volatile("" : "+s"(kf)); pg8::Gemm g{ABUF, FMAT, 512, 512, kf}; pg8::Sched S; S.init(96, 1, G, bx, 2);
          pg8::EpiF E{FBUF};
          pg8::gemm_phase(lds, wave, g, S, E); }
        asm volatile("s_waitcnt vmcnt(0)" ::: "memory");
        __syncthreads();
        if (bx < 96) {
            const float* st_re = ldp(tab, 5); const float* st_im = ldp(tab, 6);
            const int gg = bx / 3, ui = bx % 3, tid = wave * 64 + lane_id();
            const int nseq = ui == 0 ? 2048 : 256;
            for (int sq = tid; sq < nseq; sq += NTHR) {
                const int p = sq & 63, dir = (sq >> 6) & 1, bb = ui == 0 ? (sq >> 7) : 16 + (ui - 1) * 2 + (sq >> 7);
            const int nch = bb < 16 ? 16 : 128, cb0 = bb < 16 ? bb * 16 : 256 + (bb - 16) * 128;
            const f32x2 L16 = LPOW[((size_t)(dir * 32 + gg) * 17 + 16) * 64 + p];
            f32x2 S = (f32x2){0.f, 0.f};
            if (bb >= 16) { const size_t si = ((size_t)((bb - 16) * 2 + dir) * 32 + gg) * 64 + p; S = (f32x2){st_re[si], st_im[si]}; }
            f32x2 fa[16], fb[16];
#define SCAN_LOAD(dst, q0) { _Pragma("unroll") for (int u = 0; u < 16; ++u) { const int c = dir == 0 ? (q0) + u : nch - 1 - (q0) - u; dst[u] = *(const f32x2*)(FBUF + ((size_t)gg * 768 + cb0 + c) * 256 + dir * 128 + p * 2); } }
#define SCAN_STEP(src_, q0) { _Pragma("unroll") for (int u = 0; u < 16; ++u) { const int c = dir == 0 ? (q0) + u : nch - 1 - (q0) - u; \
                    ((unsigned*)ABUF)[(((size_t)gg * 768 + cb0 + c) * 512 + 256 + dir * 128 + p * 2) >> 1] = cvt_pk_bf16(S.x, S.y); S = cmul(L16, S) + src_[u]; } }
            SCAN_LOAD(fa, 0);
            for (int q0 = 0; q0 < nch; q0 += 32) {
                if (q0 + 16 < nch) SCAN_LOAD(fb, q0 + 16);
                SCAN_STEP(fa, q0);
                if (q0 + 16 < nch) { if (q0 + 32 < nch) SCAN_LOAD(fa, q0 + 32); SCAN_STEP(fb, q0 + 16); }
            }
#undef SCAN_LOAD
#undef SCAN_STEP
            if (bb < 16) { const size_t oi = ((size_t)(bb * 2 + dir) * 32 + gg) * 64 + p; out[O_SRE + oi] = S.x; out[O_SIM + oi] = S.y; }
            }
            asm volatile("s_waitcnt vmcnt(0)" ::: "memory");
            __syncthreads();
        }
        { pg8::Gemm g{ABUF, BMAT, 512, 512, 512}; pg8::Sched S; S.init(96, 1, G, bx, 2);
          pg8::EpiY E{YBUF};
          pg8::gemm_phase(lds, wave, g, S, E); }
        if (G == 256) {
            if (bx >= 96) {
                ctx_block_unit(vcu, QKV, VTP, Z, lds, wave, lane_id());
                const int jq = ((bx - 96) & 7) * 20 + ((bx - 96) >> 3);
                na_block_unit(2 * jq, QKV, VTS, KC, VTC, rpb_l, Z, lds, wave, lane_id());
                na_block_unit(2 * jq + 1, QKV, VTS, KC, VTC, rpb_l, Z, lds, wave, lane_id());
            }
        } else {
            for (int bu = vcu; bu < 768; bu += G) {
                const int ln = lane_id();
                if (bu < 256) ctx_block_unit(bu, QKV, VTP, Z, lds, wave, ln);
                else na_block_unit(bu - 256, QKV, VTS, KC, VTC, rpb_l, Z, lds, wave, ln);
            }
        }
    }
    SEAM(12);
    if (IN(13)) REP(13) {
        const float* glu_b = ldp(tab, 30);

        pg8::Gemm g{YBUF, GLUT, 512, 512, 512}; pg8::Sched S; S.init(48, 2, G, bx, 0);
        pg8::EpiGLU E{YBUF, Z, glu_b};
        pg8::gemm_phase(lds, wave, g, S, E);
        if (G == 256 && bx >= 96) {
            const int jq = ((bx - 96) & 7) * 20 + ((bx - 96) >> 3);
            na_block_unit(320 + jq, QKV, VTS, KC, VTC, rpb_l, Z, lds, wave, lane_id());
            if (jq < 32) na_block_unit(480 + jq, QKV, VTS, KC, VTC, rpb_l, Z, lds, wave, lane_id());
        }
        if (G == 256 && bx < 96) ctx_block_unit(vcu, QKV, VTP, Z, lds, wave, lane_id());
    }
    SEAM(13);
    if (IN(14)) REP(14) {
        pg8::Gemm g{Z, WOUT1, 1024, 1024, 1024}; pg8::Sched S; S.init(48, 4, G, bx, 3);
        pg8::EpiResGateNorm E{nullptr, nullptr, X, MODS + 5 * 6144 + 2 * 1024, ldp(tab, 9) + 1024, MODS + 5 * 6144, 3, H, XBUF + (size_t)2 * NTOK * 4, PCNT + 2 * 48 * 64, lds + LDS_XOFF};
        pg8::gemm_phase(lds, wave, g, S, E);
    }
    SEAM2(14, 16);
    if (IN(16)) REP(16) {
        pg8::Gemm g{H, W1_1, 1024, 1024, 1024}; pg8::Sched S; S.init(48, 16, G, bx, 0);
        pg8::EpiStore<1> E{HID, 4096};
        pg8::gemm_phase(lds, wave, g, S, E);
    }
    SEAM(16);
    if (IN(17)) REP(17) {
        pg8::Gemm g{HID, W2_1, 4096, 4096, 4096}; pg8::Sched S; S.init(48, 4, G, bx, 3);
        pg8::EpiResGateNorm E{nullptr, nullptr, X, MODS + 5 * 6144 + 5 * 1024, ldp(tab, 32), MODS, 0, nullptr, XBUF + (size_t)3 * NTOK * 4, PCNT + 3 * 48 * 64, lds + LDS_XOFF};
        pg8::gemm_phase(lds, wave, g, S, E);
    }
#undef IN
#undef SEAM
#undef SEAM2
}

extern "C" void kernel_launch(void* const* d_in, const int* in_sizes, int n_in, void* d_out, int out_size, void* d_ws, size_t ws_size, hipStream_t stream) {
    static int grid = 0;
    if (grid == 0) {
        if (n_in != 33 || ws_size < WS_END) { fprintf(stderr, "kernel_launch: unexpected n_in %d / ws_size %zu\n", n_in, ws_size); grid = -1; return; }
        int dev = 0, cus = 0, per_cu = 0;
        hipGetDevice(&dev);
        hipDeviceGetAttribute(&cus, hipDeviceAttributeMultiprocessorCount, dev);
        if (hipFuncSetAttribute((const void*)fwd_megakernel, hipFuncAttributeMaxDynamicSharedMemorySize, LDS_BYTES) != hipSuccess) { fprintf(stderr, "kernel_launch: hipFuncSetAttribute failed\n"); grid = -1; return; }
        if (hipOccupancyMaxActiveBlocksPerMultiprocessor(&per_cu, (const void*)fwd_megakernel, NTHR, LDS_BYTES) != hipSuccess || per_cu < 1) { fprintf(stderr, "kernel_launch: occupancy query gave %d\n", per_cu); per_cu = 1; (void)hipGetLastError(); }
        grid = cus;
        fprintf(stderr, "kernel_launch: cus %d per_cu %d grid %d\n", cus, per_cu, grid);
    }
    if (grid < 0) return;
    Args a{};
    for (int i = 0; i < 33; ++i) a.in[i] = (const float*)d_in[i];
    a.out = (float*)d_out; a.ws = (unsigned char*)d_ws;
#if MK_N_LAUNCHES == 1
    if (hipMemsetAsync((char*)d_ws + WS_BAR, 0, 65536, stream) != hipSuccess) { fprintf(stderr, "kernel_launch: memset of barrier words failed\n"); return; }
    a.ph_lo = 0; a.ph_hi = NPHASES;
    void* kargs[] = {&a};
    hipError_t e = hipLaunchCooperativeKernel((const void*)fwd_megakernel, dim3(grid), dim3(NTHR), kargs, LDS_BYTES, stream);
    if (e != hipSuccess) fprintf(stderr, "cooperative launch failed: %s (grid %d)\n", hipGetErrorString(e), grid);
#else
    for (int ph = 0; ph < NPHASES; ++ph) {
        a.ph_lo = ph; a.ph_hi = ph + 1;
        hipLaunchKernelGGL(fwd_megakernel, dim3(grid), dim3(NTHR), LDS_BYTES, stream, a);
    }
#endif
}
```

```cpp
#include <hip/hip_runtime.h>
#include <hip/hip_cooperative_groups.h>
#include <cstdio>
#include <cstdint>
namespace cg = cooperative_groups;

#ifndef MK_N_LAUNCHES
#define MK_N_LAUNCHES 1
#endif

#define LAS __attribute__((address_space(3)))
typedef unsigned short bf16;
typedef short bf16x8 __attribute__((ext_vector_type(8)));
typedef float f32x4 __attribute__((ext_vector_type(4)));
typedef float f32x2 __attribute__((ext_vector_type(2)));
typedef unsigned u32x4 __attribute__((ext_vector_type(4)));
typedef unsigned u32x2 __attribute__((ext_vector_type(2)));

constexpr int D = 1024, NP = 4096, NS = 8192, NTOK = 12288, FF = 4096;
constexpr int NTHR = 512, NWAVES = 8;
constexpr float EPS = 1e-6f;
constexpr int LDS_BYTES = 131072 + 256 + 8192 + 15360;
constexpr int LDS_XOFF = 131072 + 256, LDS_RPB = LDS_XOFF + 8192;
constexpr int NPHASES = 19;
constexpr int QP = 1664, VPP = 384, VSP = 2176;

constexpr size_t MiB = 1u << 20;
constexpr size_t WS_MODS = 0;
constexpr size_t WS_LPOW = 256 * 1024;
constexpr size_t WS_BBAR = 1 * MiB;
constexpr size_t WS_KTAB = 2 * MiB;
constexpr size_t WS_KC = 3 * MiB;
constexpr size_t WS_VTC = 216 * MiB;
constexpr size_t WS_WIN0 = 5 * MiB, WS_WOUT0 = 9 * MiB, WS_W1_0 = 11 * MiB, WS_W2_0 = 19 * MiB;
constexpr size_t WS_WIN1 = 27 * MiB, WS_WOUT1 = 31 * MiB, WS_W1_1 = 33 * MiB, WS_W2_1 = 41 * MiB;
constexpr size_t WS_GLUT = 49 * MiB;
constexpr size_t WS_BMAT = 50 * MiB;
constexpr size_t WS_FMAT = 58 * MiB;
constexpr size_t WS_H = 66 * MiB;
constexpr size_t WS_R = 90 * MiB;
constexpr size_t WS_Z = WS_R + 48 * MiB;
constexpr size_t WS_ABUF = WS_R + 72 * MiB;
constexpr size_t WS_YBUF = 186 * MiB;
constexpr size_t WS_VTP = 198 * MiB;
constexpr size_t WS_VTS = 204 * MiB;
constexpr size_t WS_TAB = 213 * MiB;
constexpr size_t WS_BAR = 214 * MiB;
constexpr size_t WS_XBUF = 215 * MiB;
constexpr size_t WS_END = 218 * MiB;
constexpr int CNT_OFF_WORDS = 4096;

constexpr size_t O_K = (size_t)NTOK * D, O_V = O_K + 2097152, O_SRE = O_V + 2097152, O_SIM = O_SRE + 65536;

__device__ __forceinline__ unsigned cvt_pk_bf16(float lo, float hi) { unsigned r; asm volatile("v_cvt_pk_bf16_f32 %0, %1, %2" : "=v"(r) : "v"(lo), "v"(hi)); return r; }
__device__ __forceinline__ float bf_lo(unsigned u) { return __uint_as_float(u << 16); }
__device__ __forceinline__ float bf_hi(unsigned u) { return __uint_as_float(u & 0xffff0000u); }
__device__ __forceinline__ float wave_sum(float v) {
#pragma unroll
    for (int o = 1; o < 64; o <<= 1) v += __shfl_xor(v, o);
    return v;
}
__device__ __forceinline__ int lane_id() { int l; asm volatile("v_mbcnt_lo_u32_b32 %0, -1, 0\n\tv_mbcnt_hi_u32_b32 %0, -1, %0" : "=v"(l)); return l; }
__device__ __forceinline__ float fast_exp(float x) { return __builtin_amdgcn_exp2f(x * 1.44269504089f); }
__device__ __forceinline__ float sigmoidf_(float x) { return 1.0f / (1.0f + fast_exp(-x)); }
__device__ __forceinline__ float gelu_tanh(float y) {
    const float a = 0.7978845608f * (y + 0.044715f * y * y * y);
    const float t = 1.0f - 2.0f / (1.0f + fast_exp(2.0f * a));
    return 0.5f * y * (1.0f + t);
}
__device__ __forceinline__ void unpack8(const u32x4 u, float (&f)[8]) {
    f[0] = bf_lo(u.x); f[1] = bf_hi(u.x); f[2] = bf_lo(u.y); f[3] = bf_hi(u.y); f[4] = bf_lo(u.z); f[5] = bf_hi(u.z); f[6] = bf_lo(u.w); f[7] = bf_hi(u.w);
}
__device__ __forceinline__ u32x4 pack8(const float (&f)[8]) {
    u32x4 w; w.x = cvt_pk_bf16(f[0], f[1]); w.y = cvt_pk_bf16(f[2], f[3]); w.z = cvt_pk_bf16(f[4], f[5]); w.w = cvt_pk_bf16(f[6], f[7]); return w;
}
__device__ __forceinline__ int cond_of_row(int r) { return r < NP ? 4 : ((r - NP) >> 11); }

namespace pg8 {
typedef unsigned short bf16_t;
constexpr int BM = 256, BK = 64, HALF = 128, HTB = HALF * BK * 2, STAGE_BYTES = 8 * HTB, NXCD = 8, WGM = 8;
__host__ __device__ __forceinline__ int lds_byte(int r, int c) { const int st = (r >> 4) * 2 + (c >> 5), rr = r & 15, cc = c & 31, ob = rr * 64 + cc * 2; return st * 1024 + (ob ^ (((ob >> 9) & 1) << 5)); }
__host__ __device__ __forceinline__ void stage_rc(int b, int& R, int& C) { const int st = b / 1024, sb = b % 1024, swz = sb ^ (((sb >> 9) & 1) << 5); R = (st >> 1) * 16 + swz / 64; C = (st & 1) * 32 + (swz % 64) / 2; }
__host__ __device__ __forceinline__ int perm32(int rho) { const int n = rho >> 4, i = rho & 15; return 8 * (i >> 2) + 4 * n + (i & 3); }

struct Unit { int pm, pn; };
struct Gemm { const bf16_t* A; const bf16_t* Bt; int lda, ldb, K; };

struct Sched {
    int nM, nN, nwg, G, c, mode;
    __device__ void init(int nM_, int nN_, int G_, int c_, int mode_) { nM = nM_; nN = nN_; nwg = nM * nN; G = G_; c = c_; mode = mode_; }
    __device__ bool next(int i, Unit& u) const {
        const long L = (long)i * G + c; if (L >= nwg) return false;
        if (mode == 2) { u.pm = (int)L; u.pn = (int)L / 3; return true; }
        if (mode == 3) { const int x = (int)L & 7, k = (int)L >> 3; u.pm = x + 8 * (k >> 2); u.pn = k & 3; return true; }
        int wgid = (int)L; { const int q = nwg / NXCD, r = nwg % NXCD, xcd = wgid % NXCD, off = wgid / NXCD; wgid = (xcd < r ? xcd * (q + 1) : r * (q + 1) + (xcd - r) * q) + off; }
        const int nig = WGM * nN, gid = wgid / nig, fm = gid * WGM, gsz = (nM - fm) < WGM ? (nM - fm) : WGM;
        u.pm = fm + ((wgid % nig) % gsz); u.pn = (wgid % nig) / gsz;
        if (mode == 1 && u.pn >= 4) u.pn += 2;
        return true;
    }
};

template <class T, class = void> struct is_fused { static constexpr bool value = false; };
template <class T> struct is_fused<T, decltype((void)T::FUSED)> { static constexpr bool value = true; };
template <class Epi>
__device__ __forceinline__ void gemm_phase(LAS unsigned char* lds, const int wid, const Gemm g, const Sched& S, const Epi& E) {
    const int lane = lane_id(), tid = wid * 64 + lane, wr = wid >> 2, wc = wid & 3, fr = lane & 15, fq = lane >> 4;
    const int K = g.K, nt = K / BK;
    unsigned voffA[2], voffB[2];
#pragma unroll
    for (int i = 0; i < 2; ++i) { int R, C; stage_rc(tid * 16 + i * 8192, R, C); const int Rb = (R & ~31) + perm32(R & 31);
        voffA[i] = (unsigned)(R * g.lda + C) * 2u; voffB[i] = (unsigned)(Rb * g.ldb + C) * 2u; }
    const size_t kstep = (size_t)(BK * 2);
    const size_t hA = (size_t)HALF * g.lda * 2, hB = (size_t)HALF * g.ldb * 2;
    const size_t tA = 2 * hA, tB = 2 * hB;
    const unsigned ldsw = (unsigned)wid * 1024u;
    const int aoff = lds_byte(wr * 64 + fr, fq * 8), boff = lds_byte(wc * 32 + fr, fq * 8);
#define PG8_SA(b, h) (((b) * 2 + (h)) * HTB)
#define PG8_SB(b, h) ((4 + (b) * 2 + (h)) * HTB)
#define PG8_STAGE(bufoff, gbase, voff) do { _Pragma("unroll") for (int _i = 0; _i < 2; ++_i) \
        __builtin_amdgcn_global_load_lds((const unsigned*)((const char*)(gbase) + (voff)[_i]), (LAS unsigned*)(lds + (bufoff) + ldsw + _i * 8192), 16, 0, 0); } while (0)
#define PG8_LDA(dst, b, h) do { _Pragma("unroll") for (int m = 0; m < 4; ++m) _Pragma("unroll") for (int k = 0; k < 2; ++k) dst[m][k] = *(const LAS bf16x8*)(lds + PG8_SA(b, h) + aoff + m * 2048 + k * 1024); } while (0)
#define PG8_LDB(dst, b, h) do { _Pragma("unroll") for (int n = 0; n < 2; ++n) _Pragma("unroll") for (int k = 0; k < 2; ++k) dst[n][k] = *(const LAS bf16x8*)(lds + PG8_SB(b, h) + boff + n * 2048 + k * 1024); } while (0)
#define PG8_MMA(ai, bj, At, Bt) do { __builtin_amdgcn_s_setprio(1); _Pragma("unroll") for (int m = 0; m < 4; ++m) _Pragma("unroll") for (int n = 0; n < 2; ++n) _Pragma("unroll") for (int k = 0; k < 2; ++k) \
        acc[ai][bj][m][n] = __builtin_amdgcn_mfma_f32_16x16x32_bf16(Bt[n][k], At[m][k], acc[ai][bj][m][n], 0, 0, 0); __builtin_amdgcn_s_setprio(0); } while (0)
#define PG8_WAIT_V(n) asm volatile("s_waitcnt vmcnt(" #n ")" ::: "memory")
#define PG8_WAIT_L(n) asm volatile("s_waitcnt lgkmcnt(" #n ")" ::: "memory")
#define PG8_BAR __builtin_amdgcn_s_barrier()
#define PG8_SCHED __builtin_amdgcn_sched_barrier(0)
    Unit cur, nxt; int ui = 0;
    if (!S.next(0, cur)) return;
    f32x4 acc[2][2][4][2];
#pragma unroll
    for (int a = 0; a < 2; ++a)
#pragma unroll
        for (int b = 0; b < 2; ++b)
#pragma unroll
            for (int m = 0; m < 4; ++m)
#pragma unroll
                for (int n = 0; n < 2; ++n) acc[a][b][m][n] = (f32x4){0.f, 0.f, 0.f, 0.f};
    bf16x8 At[4][2], B0[2][2], B1[2][2];
    const char* cA = (const char*)g.A + (size_t)cur.pm * tA; const char* cB = (const char*)g.Bt + (size_t)cur.pn * tB;
    PG8_STAGE(PG8_SB(0, 0), cB, voffB); PG8_STAGE(PG8_SB(0, 1), cB + hB, voffB); PG8_STAGE(PG8_SA(0, 0), cA, voffA); PG8_STAGE(PG8_SA(0, 1), cA + hA, voffA);
    if (wr == 1) PG8_BAR;
    PG8_WAIT_V(2); PG8_BAR;
    PG8_STAGE(PG8_SB(1, 0), cB + kstep, voffB); PG8_STAGE(PG8_SA(1, 0), cA + kstep, voffA); PG8_STAGE(PG8_SB(1, 1), cB + hB + kstep, voffB);
    PG8_WAIT_V(6); PG8_BAR;
    for (;;) {
        const bool has_next = S.next(ui + 1, nxt);
        const char* nA = has_next ? (const char*)g.A + (size_t)nxt.pm * tA : cA; const char* nB = has_next ? (const char*)g.Bt + (size_t)nxt.pn * tB : cB;
        for (int t = 0; t < nt; t += 2) {
            const bool last = (t == nt - 2);
            const char* a1 = cA + (size_t)(t + 1) * kstep;
            const char* a2 = last ? nA : cA + (size_t)(t + 2) * kstep; const char* b2 = last ? nB : cB + (size_t)(t + 2) * kstep;
            const char* a3 = a2 + kstep; const char* b3 = b2 + kstep;
            PG8_LDB(B0, 0, 0); PG8_LDB(B1, 0, 1); PG8_SCHED; PG8_LDA(At, 0, 0); PG8_STAGE(PG8_SA(1, 1), a1 + hA, voffA);
            PG8_WAIT_V(8); PG8_WAIT_L(0); PG8_BAR; PG8_MMA(0, 0, At, B0); PG8_MMA(0, 1, At, B1); PG8_BAR; PG8_SCHED;
            PG8_LDA(At, 0, 1); PG8_STAGE(PG8_SB(0, 0), b2, voffB); PG8_STAGE(PG8_SB(0, 1), b2 + hB, voffB); PG8_STAGE(PG8_SA(0, 0), a2, voffA);
            PG8_WAIT_V(8); PG8_WAIT_L(0); PG8_BAR; PG8_MMA(1, 0, At, B0); PG8_MMA(1, 1, At, B1); PG8_BAR; PG8_SCHED;
            PG8_LDB(B0, 1, 0); PG8_LDB(B1, 1, 1); PG8_SCHED; PG8_LDA(At, 1, 0); PG8_STAGE(PG8_SA(0, 1), a2 + hA, voffA);
            PG8_WAIT_V(8); PG8_WAIT_L(0); PG8_BAR; PG8_MMA(0, 0, At, B0); PG8_MMA(0, 1, At, B1); PG8_BAR; PG8_SCHED;
            PG8_LDA(At, 1, 1); PG8_STAGE(PG8_SB(1, 0), b3, voffB); PG8_STAGE(PG8_SB(1, 1), b3 + hB, voffB); PG8_STAGE(PG8_SA(1, 0), a3, voffA);
            PG8_WAIT_V(8); PG8_WAIT_L(0); PG8_BAR; PG8_MMA(1, 0, At, B0); PG8_MMA(1, 1, At, B1); PG8_BAR; PG8_SCHED;
        }
        if (wr == 0) PG8_BAR;
        if constexpr (is_fused<Epi>::value) E.fused(acc, cur, wr, wc, fr, fq, wid, lane); else E(acc, cur, wr, wc, fr, fq);
        if (!has_next) break;
#pragma unroll
        for (int a = 0; a < 2; ++a)
#pragma unroll
            for (int b = 0; b < 2; ++b)
#pragma unroll
                for (int m = 0; m < 4; ++m)
#pragma unroll
                    for (int n = 0; n < 2; ++n) acc[a][b][m][n] = (f32x4){0.f, 0.f, 0.f, 0.f};
        cur = nxt; cA = nA; cB = nB; ++ui;
        if (wr == 1) PG8_BAR;
    }
    PG8_WAIT_V(0);
    PG8_BAR;
#undef PG8_SA
#undef PG8_SB
#undef PG8_STAGE
#undef PG8_LDA
#undef PG8_LDB
#undef PG8_MMA
#undef PG8_WAIT_V
#undef PG8_WAIT_L
#undef PG8_BAR
#undef PG8_SCHED
}

template <int ACT  > struct EpiStore {
    bf16_t* O; int ldc;
    __device__ __forceinline__ void operator()(const f32x4 (&acc)[2][2][4][2], const Unit& u, int wr, int wc, int fr, int fq) const {
        const int row0 = u.pm * BM + wr * 64 + fr, col0 = u.pn * BM + wc * 32 + 8 * fq;
#pragma unroll
        for (int ai = 0; ai < 2; ++ai)
#pragma unroll
            for (int m = 0; m < 4; ++m) { bf16_t* rowp = O + (size_t)(row0 + ai * HALF + m * 16) * ldc + col0;
#pragma unroll
                for (int bj = 0; bj < 2; ++bj) { f32x4 v0 = acc[ai][bj][m][0], v1 = acc[ai][bj][m][1];
                    if (ACT == 1) {
#pragma unroll
                        for (int i = 0; i < 4; ++i) { const float a = fmaxf(v0[i], 0.f), b = fmaxf(v1[i], 0.f); v0[i] = a * a; v1[i] = b * b; } }
                    u32x4 w; w.x = cvt_pk_bf16(v0[0], v0[1]); w.y = cvt_pk_bf16(v0[2], v0[3]); w.z = cvt_pk_bf16(v1[0], v1[1]); w.w = cvt_pk_bf16(v1[2], v1[3]);
                    *(u32x4*)(rowp + bj * HALF) = w; } }
    }
};
struct EpiResGate {
    const float* xp; const float* xs; float* out; const float* gates;
    __device__ __forceinline__ void operator()(const f32x4 (&acc)[2][2][4][2], const Unit& u, int wr, int wc, int fr, int fq) const {
        const int rb = u.pm * BM; const float* gate = gates + cond_of_row(rb) * 6144;
        const float* base = xp ? (rb < NP ? xp : xs - (size_t)NP * D) : out;
        const int row0 = rb + wr * 64 + fr, col0 = u.pn * BM + wc * 32 + 8 * fq;
        f32x4 gv[2][2];
#pragma unroll
        for (int bj = 0; bj < 2; ++bj)
#pragma unroll
            for (int n = 0; n < 2; ++n) gv[bj][n] = *(const f32x4*)(gate + col0 + bj * HALF + 4 * n);
#pragma unroll
        for (int ai = 0; ai < 2; ++ai)
#pragma unroll
            for (int m = 0; m < 4; ++m) { const size_t ro = (size_t)(row0 + ai * HALF + m * 16) * D + col0;
#pragma unroll
                for (int bj = 0; bj < 2; ++bj)
#pragma unroll
                    for (int n = 0; n < 2; ++n) { const f32x4 b = *(const f32x4*)(base + ro + bj * HALF + 4 * n);
                        *(f32x4*)(out + ro + bj * HALF + 4 * n) = b + gv[bj][n] * acc[ai][bj][m][n]; } }
    }
};
struct EpiResGateNorm {
    static constexpr bool FUSED = true;
    const float* xp; const float* xs; float* out; const float* gates;
    const float* gam; const float* modn; int sidx; bf16_t* Hn;
    float* xbuf; unsigned* cnt; LAS unsigned char* l2;
    __device__ __forceinline__ void fused(f32x4 (&acc)[2][2][4][2], const Unit& u, int wr, int wc, int fr, int fq, int wid, int lane) const {
        LAS float* P = (LAS float*)l2;
        LAS float* S = (LAS float*)(l2 + 4096);
        const int rb = u.pm * BM; const int cnd = cond_of_row(rb); const float* gate = gates + cnd * 6144;
        const float* base = xp ? (rb < NP ? xp : xs - (size_t)NP * D) : out;
        const int row0 = rb + wr * 64 + fr, col0 = u.pn * BM + wc * 32 + 8 * fq;
        {
            f32x4 gv[2][2];
#pragma unroll
            for (int bj = 0; bj < 2; ++bj)
#pragma unroll
                for (int n = 0; n < 2; ++n) gv[bj][n] = *(const f32x4*)(gate + col0 + bj * HALF + 4 * n);
#pragma unroll
            for (int am = 0; am < 4; ++am) {
                const int ai = am >> 1, m0 = (am & 1) * 2;
                f32x4 bb[2][2][2];
#pragma unroll
                for (int mm = 0; mm < 2; ++mm)
#pragma unroll
                    for (int bj = 0; bj < 2; ++bj)
#pragma unroll
                        for (int n = 0; n < 2; ++n) bb[mm][bj][n] = *(const f32x4*)(base + (size_t)(row0 + ai * HALF + (m0 + mm) * 16) * D + col0 + bj * HALF + 4 * n);
#pragma unroll
                for (int mm = 0; mm < 2; ++mm) { const int m = m0 + mm; const size_t ro = (size_t)(row0 + ai * HALF + m * 16) * D + col0; float s = 0.f;
#pragma unroll
                    for (int bj = 0; bj < 2; ++bj)
#pragma unroll
                        for (int n = 0; n < 2; ++n) {
                            const f32x4 v = bb[mm][bj][n] + gv[bj][n] * acc[ai][bj][m][n]; acc[ai][bj][m][n] = v;
                            s += (v[0] * v[0] + v[1] * v[1]) + (v[2] * v[2] + v[3] * v[3]); }
                    s += __shfl_xor(s, 16); s += __shfl_xor(s, 32);
                    if (fq == 0) P[(ai * HALF + wr * 64 + m * 16 + fr) * 4 + wc] = s; }
            }
        }
        asm volatile("s_waitcnt lgkmcnt(0)" ::: "memory"); __builtin_amdgcn_s_barrier(); asm volatile("" ::: "memory");
        const int prow = wid * 32 + (lane & 31);
        if (lane < 32) {
            const float tot = (P[prow * 4 + 0] + P[prow * 4 + 1]) + (P[prow * 4 + 2] + P[prow * 4 + 3]);
            __hip_atomic_store(xbuf + ((size_t)(rb + prow) * 4 + u.pn), tot, __ATOMIC_RELAXED, __HIP_MEMORY_SCOPE_AGENT);
        }
        asm volatile("s_waitcnt vmcnt(0)" ::: "memory");
        if (lane == 0) __hip_atomic_fetch_add(cnt + 64 * u.pm, 1u, __ATOMIC_RELAXED, __HIP_MEMORY_SCOPE_AGENT);
        if (Hn) {
#pragma unroll
            for (int ai = 0; ai < 2; ++ai)
#pragma unroll
                for (int m = 0; m < 4; ++m) { float* op = out + (size_t)(row0 + ai * HALF + m * 16) * D + col0;
#pragma unroll
                    for (int bj = 0; bj < 2; ++bj)
#pragma unroll
                        for (int n = 0; n < 2; ++n) *(f32x4*)(op + bj * HALF + 4 * n) = acc[ai][bj][m][n]; }
        }
        if (wid == 0) {
            unsigned sp = 0;
            for (;;) {
                if ((unsigned)__builtin_amdgcn_readfirstlane(__hip_atomic_load(cnt + 64 * u.pm, __ATOMIC_RELAXED, __HIP_MEMORY_SCOPE_AGENT)) >= 32u) break;
                if (++sp > (1u << 20)) break;
                __builtin_amdgcn_s_sleep(2);
            }
            __builtin_amdgcn_fence(__ATOMIC_ACQUIRE, "agent");
        }
        asm volatile("s_waitcnt vmcnt(0) lgkmcnt(0)" ::: "memory"); __builtin_amdgcn_s_barrier(); asm volatile("" ::: "memory");
        if (lane < 32) {
            const float* slot = xbuf + (size_t)(rb + prow) * 4; float tot = 0.f;
#pragma unroll
            for (int t = 0; t < 4; ++t) tot += __hip_atomic_load(slot + t, __ATOMIC_RELAXED, __HIP_MEMORY_SCOPE_AGENT);
            S[prow] = 1.0f / sqrtf(tot * (1.0f / D) + EPS);
        }
        asm volatile("s_waitcnt vmcnt(0) lgkmcnt(0)" ::: "memory"); __builtin_amdgcn_s_barrier(); asm volatile("" ::: "memory");
        const float* sh = modn + cnd * 6144 + sidx * 1024; const float* sc = sh + 1024;
#pragma unroll
        for (int bj = 0; bj < 2; ++bj) {
            const int c = col0 + bj * HALF;
            f32x4 g0 = *(const f32x4*)(gam + c), g1 = *(const f32x4*)(gam + c + 4), h0 = (f32x4){0.f, 0.f, 0.f, 0.f}, h1 = h0;
            if (Hn) { g0 = g0 * (*(const f32x4*)(sc + c) + 1.0f); g1 = g1 * (*(const f32x4*)(sc + c + 4) + 1.0f); h0 = *(const f32x4*)(sh + c); h1 = *(const f32x4*)(sh + c + 4); }
#pragma unroll
            for (int ai = 0; ai < 2; ++ai)
#pragma unroll
                for (int m = 0; m < 4; ++m) { const int rl = ai * HALF + wr * 64 + m * 16 + fr; const float rstd = S[rl];
                    const f32x4 o0 = acc[ai][bj][m][0] * rstd * g0 + h0, o1 = acc[ai][bj][m][1] * rstd * g1 + h1;
                    if (Hn) { u32x4 w; w.x = cvt_pk_bf16(o0[0], o0[1]); w.y = cvt_pk_bf16(o0[2], o0[3]); w.z = cvt_pk_bf16(o1[0], o1[1]); w.w = cvt_pk_bf16(o1[2], o1[3]);
                        *(u32x4*)(Hn + (size_t)(rb + rl) * D + c) = w; }
                    else { float* o = out + (size_t)(rb + rl) * D + c; *(f32x4*)o = o0; *(f32x4*)(o + 4) = o1; } }
        }
    }
};
struct EpiProj1 {
    bf16_t* QKV; bf16_t* ABUF; float* outK;
    __device__ __forceinline__ void operator()(const f32x4 (&acc)[2][2][4][2], const Unit& u, int wr, int wc, int fr, int fq) const {
        const int row0 = u.pm * BM + wr * 64 + fr, col0 = u.pn * BM + wc * 32 + 8 * fq;
#pragma unroll
        for (int ai = 0; ai < 2; ++ai)
#pragma unroll
            for (int m = 0; m < 4; ++m) { const int r = row0 + ai * HALF + m * 16;
#pragma unroll
                for (int bj = 0; bj < 2; ++bj) { const int c = col0 + bj * HALF; const f32x4 v0 = acc[ai][bj][m][0], v1 = acc[ai][bj][m][1];
                    u32x4 w; w.x = cvt_pk_bf16(v0[0], v0[1]); w.y = cvt_pk_bf16(v0[2], v0[3]); w.z = cvt_pk_bf16(v1[0], v1[1]); w.w = cvt_pk_bf16(v1[2], v1[3]);
                    if (u.pn < 4) {
                        *(u32x4*)(QKV + (size_t)r * QP + c) = w;
                        if (u.pn >= 2 && r < NP) { const int b = r >> 8, t = r & 255, hh = (c - 512) >> 6, d = (c - 512) & 63;
                            float* o = outK + ((size_t)((b * 8 + hh) * 256 + t)) * 64 + d; *(f32x4*)o = v0; *(f32x4*)(o + 4) = v1; }
                    } else { const int cu = c - 1536, gg = cu >> 4, gi0 = cu & 15, chunk = r >> 4, j = r & 15;
                        *(u32x4*)(ABUF + ((size_t)(gg * 768 + chunk)) * 512 + j * 16 + gi0) = w; }
                } }
    }
};
struct EpiVT {
    bf16_t* VTP; bf16_t* VTS; float* outV;
    __device__ __forceinline__ void operator()(const f32x4 (&acc)[2][2][4][2], const Unit& u, int wr, int wc, int fr, int fq) const {
        const int row0 = u.pm * BM + wr * 64 + fr, col0 = u.pn * BM + wc * 32 + 8 * fq;
#pragma unroll
        for (int ai = 0; ai < 2; ++ai)
#pragma unroll
            for (int m = 0; m < 4; ++m) { const int c = row0 + ai * HALF + m * 16, hh = c >> 6, d = c & 63;
#pragma unroll
                for (int bj = 0; bj < 2; ++bj) { const int r0 = col0 + bj * HALF; const f32x4 v0 = acc[ai][bj][m][0], v1 = acc[ai][bj][m][1];
                    u32x4 w; w.x = cvt_pk_bf16(v0[0], v0[1]); w.y = cvt_pk_bf16(v0[2], v0[3]); w.z = cvt_pk_bf16(v1[0], v1[1]); w.w = cvt_pk_bf16(v1[2], v1[3]);
                    if (r0 < NP) { const int b = r0 >> 8, t0 = r0 & 255;
                        *(u32x4*)(VTP + ((size_t)((b * 8 + hh) * 64 + d)) * VPP + t0) = w;
                        float* o = outV + ((size_t)((b * 8 + hh) * 256 + t0)) * 64 + d;
#pragma unroll
                        for (int i = 0; i < 4; ++i) { o[i * 64] = v0[i]; o[(i + 4) * 64] = v1[i]; }
                    } else { const int rs = r0 - NP, b = rs >> 11, t0 = rs & 2047;
                        *(u32x4*)(VTS + ((size_t)((b * 8 + hh) * 64 + d)) * VSP + t0) = w; }
                } }
    }
};
struct EpiF {
    float* F;
    __device__ __forceinline__ void operator()(const f32x4 (&acc)[2][2][4][2], const Unit& u, int wr, int wc, int fr, int fq) const {
        const int row0 = u.pm * BM + wr * 64 + fr, col0 = wc * 32 + 8 * fq;
#pragma unroll
        for (int ai = 0; ai < 2; ++ai)
#pragma unroll
            for (int m = 0; m < 4; ++m) { float* rowp = F + (size_t)(row0 + ai * HALF + m * 16) * 256 + col0;
#pragma unroll
                for (int bj = 0; bj < 2; ++bj) { *(f32x4*)(rowp + bj * HALF) = acc[ai][bj][m][0]; *(f32x4*)(rowp + bj * HALF + 4) = acc[ai][bj][m][1]; } }
    }
};
struct EpiY {
    bf16_t* Y;
    __device__ __forceinline__ void operator()(const f32x4 (&acc)[2][2][4][2], const Unit& u, int wr, int wc, int fr, int fq) const {
        const int gg = u.pn, row0 = u.pm * BM + wr * 64 + fr - gg * 768, col0 = wc * 32 + 8 * fq;
#pragma unroll
        for (int ai = 0; ai < 2; ++ai)
#pragma unroll
            for (int m = 0; m < 4; ++m) { const int chunk = row0 + ai * HALF + m * 16;
#pragma unroll
                for (int bj = 0; bj < 2; ++bj) { const int n = col0 + bj * HALF, t = n >> 4, go0 = n & 15; const f32x4 v0 = acc[ai][bj][m][0], v1 = acc[ai][bj][m][1];
                    u32x4 w; w.x = cvt_pk_bf16(gelu_tanh(v0[0]), gelu_tanh(v0[1])); w.y = cvt_pk_bf16(gelu_tanh(v0[2]), gelu_tanh(v0[3]));
                    w.z = cvt_pk_bf16(gelu_tanh(v1[0]), gelu_tanh(v1[1])); w.w = cvt_pk_bf16(gelu_tanh(v1[2]), gelu_tanh(v1[3]));
                    *(u32x4*)(Y + ((size_t)(chunk * 16 + t)) * 512 + gg * 16 + go0) = w; } }
    }
};
struct EpiGLU {
    const bf16_t* Y; bf16_t* Z; const float* bias;
    __device__ __forceinline__ void operator()(const f32x4 (&acc)[2][2][4][2], const Unit& u, int wr, int wc, int fr, int fq) const {
        const int row0 = u.pm * BM + wr * 64 + fr, col0 = u.pn * BM + wc * 32 + 8 * fq;
#pragma unroll
        for (int ai = 0; ai < 2; ++ai)
#pragma unroll
            for (int m = 0; m < 4; ++m) { const int r = row0 + ai * HALF + m * 16;
#pragma unroll
                for (int bj = 0; bj < 2; ++bj) { const int c = col0 + bj * HALF; const f32x4 v0 = acc[ai][bj][m][0], v1 = acc[ai][bj][m][1];
                    const u32x4 yu = *(const u32x4*)(Y + (size_t)r * 512 + c); float y[8]; unpack8(yu, y);
                    const f32x4 b0 = *(const f32x4*)(bias + c), b1 = *(const f32x4*)(bias + c + 4);
                    float o[8];
#pragma unroll
                    for (int i = 0; i < 4; ++i) { o[i] = y[i] * sigmoidf_(v0[i] + b0[i]); o[i + 4] = y[i + 4] * sigmoidf_(v1[i] + b1[i]); }
                    *(u32x4*)(Z + (size_t)r * D + 512 + c) = pack8(o); } }
    }
};
}

__device__ __forceinline__ void tr_item(const float* W, int N, bf16* WT, int ldt, LAS float* scr, int item, int lane) {
    const int nblk = N / 32, kb = item / nblk, nb = item % nblk, k0 = 64 * kb, n0 = 32 * nb;
    float tv[32];
#pragma unroll
    for (int i = 0; i < 32; ++i) tv[i] = W[(size_t)(k0 + 2 * i + (lane >> 5)) * N + n0 + (lane & 31)];
#pragma unroll
    for (int i = 0; i < 32; ++i) scr[(2 * i + (lane >> 5)) * 33 + (lane & 31)] = tv[i];
    asm volatile("s_waitcnt lgkmcnt(0)" ::: "memory");
    const int c = lane & 7;
#pragma unroll
    for (int j = 0; j < 4; ++j) { const int n = (lane >> 3) + 8 * j; const LAS float* s = scr + (8 * c) * 33 + n;
        u32x4 o; o.x = cvt_pk_bf16(s[0 * 33], s[1 * 33]); o.y = cvt_pk_bf16(s[2 * 33], s[3 * 33]); o.z = cvt_pk_bf16(s[4 * 33], s[5 * 33]); o.w = cvt_pk_bf16(s[6 * 33], s[7 * 33]);
        *(u32x4*)(WT + (size_t)(n0 + n) * ldt + k0 + 8 * c) = o; }
    asm volatile("s_waitcnt lgkmcnt(0)" ::: "memory");
}

__device__ __forceinline__ f32x2 cmul(f32x2 a, f32x2 b) { return (f32x2){a.x * b.x - a.y * b.y, a.x * b.y + a.y * b.x}; }
__device__ __forceinline__ f32x2 lam_pow(float lre, float lim, float st, int d) {
    const float mag = fast_exp(lre * st * (float)d);
    const double rev = (double)lim * (double)st * (double)d * 0.15915494309189535;
    const float fr = (float)(rev - __builtin_rint(rev));
    return (f32x2){mag * __builtin_amdgcn_cosf(fr), mag * __builtin_amdgcn_sinf(fr)};
}

__device__ __forceinline__ void rms_mod_rows(const float* xp, const float* xs_m, bf16* H, const float* gam, const float* modl, int sidx, int gw, int NGW, int lane) {
    for (int r = gw; r < NTOK; r += 2 * NGW) {
        const int r1 = r + NGW; const bool has1 = r1 < NTOK; const int r1c = has1 ? r1 : r;
        const float* xr0 = (r < NP ? xp : xs_m) + (size_t)r * D; const float* xr1 = (r1c < NP ? xp : xs_m) + (size_t)r1c * D;
        f32x4 v0[4], v1[4]; float s0 = 0.f, s1 = 0.f;
#pragma unroll
        for (int j = 0; j < 4; ++j) { v0[j] = *((const f32x4*)xr0 + lane + 64 * j); v1[j] = *((const f32x4*)xr1 + lane + 64 * j); }
#pragma unroll
        for (int j = 0; j < 4; ++j) { s0 += (v0[j].x * v0[j].x + v0[j].y * v0[j].y) + (v0[j].z * v0[j].z + v0[j].w * v0[j].w);
                                      s1 += (v1[j].x * v1[j].x + v1[j].y * v1[j].y) + (v1[j].z * v1[j].z + v1[j].w * v1[j].w); }
        const float rstd0 = 1.0f / sqrtf(wave_sum(s0) * (1.f / D) + EPS), rstd1 = 1.0f / sqrtf(wave_sum(s1) * (1.f / D) + EPS);
        const float* sh0 = modl + cond_of_row(r) * 6144 + sidx * 1024; const float* sh1 = modl + cond_of_row(r1c) * 6144 + sidx * 1024;
#pragma unroll
        for (int j = 0; j < 4; ++j) { const int c = 4 * (lane + 64 * j);
            const f32x4 g4 = *(const f32x4*)(gam + c);
            { const f32x4 s4 = *(const f32x4*)(sh0 + 1024 + c), h4 = *(const f32x4*)(sh0 + c); const f32x4 o = (v0[j] * rstd0) * g4 * (s4 + 1.0f) + h4;
              u32x2 w; w.x = cvt_pk_bf16(o.x, o.y); w.y = cvt_pk_bf16(o.z, o.w); *(u32x2*)(H + (size_t)r * D + c) = w; }
            if (has1) { const f32x4 s4 = *(const f32x4*)(sh1 + 1024 + c), h4 = *(const f32x4*)(sh1 + c); const f32x4 o = (v1[j] * rstd1) * g4 * (s4 + 1.0f) + h4;
              u32x2 w; w.x = cvt_pk_bf16(o.x, o.y); w.y = cvt_pk_bf16(o.z, o.w); *(u32x2*)(H + (size_t)r1 * D + c) = w; }
        }
    }
}

__device__ __forceinline__ void wait_vm(int n) {
    switch (n) {
        case 0: asm volatile("s_waitcnt vmcnt(0)" ::: "memory"); break;   case 1: asm volatile("s_waitcnt vmcnt(1)" ::: "memory"); break;
        case 2: asm volatile("s_waitcnt vmcnt(2)" ::: "memory"); break;   case 3: asm volatile("s_waitcnt vmcnt(3)" ::: "memory"); break;
        case 4: asm volatile("s_waitcnt vmcnt(4)" ::: "memory"); break;   case 5: asm volatile("s_waitcnt vmcnt(5)" ::: "memory"); break;
        case 6: asm volatile("s_waitcnt vmcnt(6)" ::: "memory"); break;   case 7: asm volatile("s_waitcnt vmcnt(7)" ::: "memory"); break;
        case 8: asm volatile("s_waitcnt vmcnt(8)" ::: "memory"); break;   case 9: asm volatile("s_waitcnt vmcnt(9)" ::: "memory"); break;
        case 10: asm volatile("s_waitcnt vmcnt(10)" ::: "memory"); break; case 11: asm volatile("s_waitcnt vmcnt(11)" ::: "memory"); break;
        case 12: asm volatile("s_waitcnt vmcnt(12)" ::: "memory"); break; case 13: asm volatile("s_waitcnt vmcnt(13)" ::: "memory"); break;
        case 14: asm volatile("s_waitcnt vmcnt(14)" ::: "memory"); break; default: asm volatile("s_waitcnt vmcnt(15)" ::: "memory"); break;
    }
}
__device__ __forceinline__ void dma16(const bf16* g, LAS unsigned char* l) { __builtin_amdgcn_global_load_lds((const unsigned*)g, (LAS unsigned*)l, 16, 0, 0); }
template <bool BIAS, int kpitchA, int rsA, int vpitchA>
__device__ __forceinline__ void attn_seg(const bf16x8 qf0, const bf16x8 qf1, const bf16* kA, const bf16* vtA, LAS unsigned char* wl,
                                         const LAS float* rpbh, int r, int r0, int s0, int cb, int lane, float& mout, float& sumout, f32x4 (&o)[4]) {
    const int l16 = lane & 15, g4 = lane >> 4;
    const LAS unsigned char* rl = wl + lane * 16;
    f32x4 s[16];
    constexpr int RK = 8;
    const bf16* kbase = kA + (size_t)((l16 >> 2) * 8 + (l16 & 3)) * kpitchA + g4 * 8;
    const bf16* kr = kbase;
#pragma unroll
    for (int t = 0; t < RK - 1; ++t) { dma16(kr, wl + t * 2048); dma16(kr + 32, wl + t * 2048 + 1024);
        kr += (size_t)((t & 1) ? (rsA - 4) : 4) * kpitchA; asm volatile("" : "+v"(kr)); }
#pragma unroll
    for (int t = 0; t < 16; ++t) {
        if (t + RK - 1 < 16) { const int tn = t + RK - 1;
            dma16(kr, wl + (tn % RK) * 2048); dma16(kr + 32, wl + (tn % RK) * 2048 + 1024);
            kr += (size_t)((tn & 1) ? (rsA - 4) : 4) * kpitchA; asm volatile("" : "+v"(kr)); }
        wait_vm(2 * ((15 - t) < (RK - 1) ? (15 - t) : (RK - 1)));
        const bf16x8 a0 = *(const LAS bf16x8*)(rl + (t % RK) * 2048), a1 = *(const LAS bf16x8*)(rl + (t % RK) * 2048 + 1024);
        f32x4 z = (f32x4){0.f, 0.f, 0.f, 0.f};
        z = __builtin_amdgcn_mfma_f32_16x16x32_bf16(a0, qf0, z, 0, 0, 0);
        s[t] = __builtin_amdgcn_mfma_f32_16x16x32_bf16(a1, qf1, z, 0, 0, 0);
        __builtin_amdgcn_sched_barrier(0);
    }
    constexpr int RV = 16;
    const bf16* vbase = vtA + (size_t)l16 * vpitchA + g4 * 8;
    asm volatile("s_waitcnt lgkmcnt(0)" ::: "memory");
    const bf16* vr = vbase;
#pragma unroll
    for (int q = 0; q < RV - 1; ++q) { dma16(vr, wl + q * 1024);
        vr += ((q & 3) == 3) ? (ptrdiff_t)rsA - (ptrdiff_t)48 * vpitchA : (ptrdiff_t)16 * vpitchA; asm volatile("" : "+v"(vr)); }
    __builtin_amdgcn_sched_barrier(0);
    float mx = -3.0e38f;
    constexpr float SC = 0.125f * 1.44269504089f, L2E = 1.44269504089f;
    if (BIAS) {
        int cidx[8];
        const int qc = cb * 16 + l16; int c0 = qc - 8; c0 = c0 < 0 ? 0 : (c0 > 48 ? 48 : c0);
#pragma unroll
        for (int e = 0; e < 8; ++e) { const int x = g4 * 8 + e, kc = s0 + x; int co = kc - qc; co = co < -15 ? -15 : (co > 15 ? 15 : co);
            cidx[e] = (kc >= c0 && kc < c0 + 16) ? (co + 15) : -1; }
#pragma unroll
        for (int t = 0; t < 16; ++t) { const int y = t >> 1; const LAS float* rp = rpbh + (r0 + y - r + 7) * 31;
#pragma unroll
            for (int i = 0; i < 4; ++i) { const int ci = cidx[(t & 1) * 4 + i];
                const float bsv = rp[ci >= 0 ? ci : 0];
                const float v = ci >= 0 ? s[t][i] * SC + bsv * L2E : -1.0e30f; s[t][i] = v; mx = fmaxf(mx, v); } }
    } else {
#pragma unroll
        for (int t = 0; t < 16; ++t)
#pragma unroll
            for (int i = 0; i < 4; ++i) { const float v = s[t][i] * SC; s[t][i] = v; mx = fmaxf(mx, v); }
    }
    mx = fmaxf(mx, __shfl_xor(mx, 16)); mx = fmaxf(mx, __shfl_xor(mx, 32));
    float sum = 0.f;
#pragma unroll
    for (int dt = 0; dt < 4; ++dt) o[dt] = (f32x4){0.f, 0.f, 0.f, 0.f};
#pragma unroll
    for (int j = 0; j < 8; ++j) {
        float p[8];
#pragma unroll
        for (int i = 0; i < 4; ++i) { p[i] = __builtin_amdgcn_exp2f(s[2 * j][i] - mx); p[4 + i] = __builtin_amdgcn_exp2f(s[2 * j + 1][i] - mx); }
#pragma unroll
        for (int i = 0; i < 8; ++i) sum += p[i];
        const bf16x8 pb = __builtin_bit_cast(bf16x8, pack8(p));
#pragma unroll
        for (int dt = 0; dt < 4; ++dt) {
            const int q = j * 4 + dt, qn = q + RV - 1;
            if (qn < 32) { dma16(vr, wl + (qn % RV) * 1024);
                vr += ((qn & 3) == 3) ? (ptrdiff_t)rsA - (ptrdiff_t)48 * vpitchA : (ptrdiff_t)16 * vpitchA; asm volatile("" : "+v"(vr)); }
            wait_vm((31 - q) < (RV - 1) ? (31 - q) : (RV - 1));
            const bf16x8 vq = *(const LAS bf16x8*)(rl + (q % RV) * 1024);
            o[dt] = __builtin_amdgcn_mfma_f32_16x16x32_bf16(vq, pb, o[dt], 0, 0, 0);
            __builtin_amdgcn_sched_barrier(0);
        }
    }
    asm volatile("s_waitcnt lgkmcnt(0)" ::: "memory");
    sum += __shfl_xor(sum, 16); sum += __shfl_xor(sum, 32);
    mout = mx; sumout = sum;
}
template <bool NA>
__device__ __forceinline__ void attn_unit(const bf16* qrow, const bf16* kA, const bf16* vtA,
                                          const bf16* kB, const bf16* vtB, const LAS float* rpbh, int r, int r0, int s0, int cb, bf16* orow, int lane, LAS unsigned char* wl) {
    const int g4 = lane >> 4;
    const bf16x8 qf0 = *(const bf16x8*)(qrow + g4 * 8), qf1 = *(const bf16x8*)(qrow + 32 + g4 * 8);
    f32x4 o[4]; float m, sum;
    if (NA) attn_seg<true, QP, 64, VSP>(qf0, qf1, kA, vtA, wl, rpbh, r, r0, s0, cb, lane, m, sum, o);
    else attn_seg<false, QP, 32, VPP>(qf0, qf1, kA, vtA, wl, rpbh, r, r0, s0, cb, lane, m, sum, o);
    if (NA) {
        f32x4 o2[4]; float m2, sum2;
        attn_seg<false, 64, 32, VPP>(qf0, qf1, kB, vtB, wl, (const LAS float*)nullptr, 0, 0, 0, 0, lane, m2, sum2, o2);
        const float mm = fmaxf(m, m2), wa = __builtin_amdgcn_exp2f(m - mm), wb = __builtin_amdgcn_exp2f(m2 - mm);
        sum = sum * wa + sum2 * wb;
#pragma unroll
        for (int dt = 0; dt < 4; ++dt) o[dt] = o[dt] * wa + o2[dt] * wb;
    }
    const float inv = 1.0f / sum;
#pragma unroll
    for (int dt = 0; dt < 4; ++dt) { u32x2 w; w.x = cvt_pk_bf16(o[dt][0] * inv, o[dt][1] * inv); w.y = cvt_pk_bf16(o[dt][2] * inv, o[dt][3] * inv);
        *(u32x2*)(orow + dt * 16 + g4 * 4) = w; }
}


__device__ __forceinline__ int kimg_f(int kidx) { return ((kidx >> 3) & 3) | (((kidx >> 1) & 1) << 2); }
__device__ __forceinline__ int kimg_off(int kidx, int c) { return kidx * 128 + ((c ^ kimg_f(kidx)) << 4); }
__device__ __forceinline__ void stage_k(LAS unsigned char* img, const bf16* g0, int pitch, int nkeys, int wave, int lane) {
    const int kin = lane >> 3, p = lane & 7;
    for (int pc = wave; pc < (nkeys >> 3); pc += NWAVES) { const int key = pc * 8 + kin, c = p ^ kimg_f(key);
        dma16(g0 + (size_t)key * pitch + c * 8, img + pc * 1024); }
}
__device__ __forceinline__ void stage_v(LAS unsigned char* img, const bf16* g0, int gpitch, int ntok, int VB, int wave, int lane) {
    const int total = 64 * VB;
    for (int pc = wave; pc * 1024 < total; pc += NWAVES) { const int o = pc * 1024 + lane * 16; int d = o / VB, w = o - d * VB;
        if (d > 63) { d = 63; w = 0; } if (w >= ntok * 2) w = 0;
        dma16(g0 + (size_t)d * gpitch + (w >> 1), img + pc * 1024); }
}
template <bool BIAS, int RS>
__device__ __forceinline__ float qk_lds(const bf16x8 qf0, const bf16x8 qf1, const LAS unsigned char* kimg, int kwin, f32x4 (&s)[16],
                                        const LAS float* rpbh, int r, int r0, int s0, int cb, int lane) {
    const int l16 = lane & 15, g4 = lane >> 4;
    const int xl = (l16 >> 2) * 8 + (l16 & 3);
#pragma unroll
    for (int t = 0; t < 16; ++t) {
        const int kidx = kwin + (t >> 1) * RS + (t & 1) * 4 + xl;
        const bf16x8 a0 = *(const LAS bf16x8*)(kimg + kimg_off(kidx, g4)), a1 = *(const LAS bf16x8*)(kimg + kimg_off(kidx, 4 + g4));
        f32x4 z = (f32x4){0.f, 0.f, 0.f, 0.f};
        z = __builtin_amdgcn_mfma_f32_16x16x32_bf16(a0, qf0, z, 0, 0, 0);
        s[t] = __builtin_amdgcn_mfma_f32_16x16x32_bf16(a1, qf1, z, 0, 0, 0);
    }
    float mx = -3.0e38f;
    constexpr float SC = 0.125f * 1.44269504089f, L2E = 1.44269504089f;
    if (BIAS) {
        int cidx[8];
        const int qc = cb * 16 + l16; int c0 = qc - 8; c0 = c0 < 0 ? 0 : (c0 > 48 ? 48 : c0);
#pragma unroll
        for (int e = 0; e < 8; ++e) { const int x = g4 * 8 + e, kc = s0 + x; int co = kc - qc; co = co < -15 ? -15 : (co > 15 ? 15 : co);
            cidx[e] = (kc >= c0 && kc < c0 + 16) ? (co + 15) : -1; }
#pragma unroll
        for (int t = 0; t < 16; ++t) { const int y = t >> 1; const LAS float* rp = rpbh + (r0 + y - r + 7) * 31;
#pragma unroll
            for (int i = 0; i < 4; ++i) { const int ci = cidx[(t & 1) * 4 + i];
                const float bsv = rp[ci >= 0 ? ci : 0];
                const float v = ci >= 0 ? s[t][i] * SC + bsv * L2E : -1.0e30f; s[t][i] = v; mx = fmaxf(mx, v); } }
    } else {
#pragma unroll
        for (int t = 0; t < 16; ++t)
#pragma unroll
            for (int i = 0; i < 4; ++i) { const float v = s[t][i] * SC; s[t][i] = v; mx = fmaxf(mx, v); }
    }
    mx = fmaxf(mx, __shfl_xor(mx, 16)); mx = fmaxf(mx, __shfl_xor(mx, 32));
    return mx;
}
template <int RS, int VB>
__device__ __forceinline__ float pv_lds(const LAS unsigned char* vimg, int kwin, const f32x4 (&s)[16], float mx, f32x4 (&o)[4], int lane) {
    const int l16 = lane & 15, g4 = lane >> 4;
    const LAS unsigned char* vb = vimg + l16 * VB + (kwin + g4 * 8) * 2;
    float sum = 0.f;
#pragma unroll
    for (int dt = 0; dt < 4; ++dt) o[dt] = (f32x4){0.f, 0.f, 0.f, 0.f};
#pragma unroll
    for (int j = 0; j < 8; ++j) {
        float p[8];
#pragma unroll
        for (int i = 0; i < 4; ++i) { p[i] = __builtin_amdgcn_exp2f(s[2 * j][i] - mx); p[4 + i] = __builtin_amdgcn_exp2f(s[2 * j + 1][i] - mx); }
#pragma unroll
        for (int i = 0; i < 8; ++i) sum += p[i];
        const bf16x8 pb = __builtin_bit_cast(bf16x8, pack8(p));
#pragma unroll
        for (int dt = 0; dt < 4; ++dt) {
            const bf16x8 vq = *(const LAS bf16x8*)(vb + dt * 16 * VB + j * RS * 2);
            o[dt] = __builtin_amdgcn_mfma_f32_16x16x32_bf16(vq, pb, o[dt], 0, 0, 0);
        }
    }
    sum += __shfl_xor(sum, 16); sum += __shfl_xor(sum, 32);
    return sum;
}
__device__ __forceinline__ void attn_store(bf16* orow, const f32x4 (&o)[4], float sum, int lane) {
    const int g4 = lane >> 4; const float inv = 1.0f / sum;
#pragma unroll
    for (int dt = 0; dt < 4; ++dt) { u32x2 w; w.x = cvt_pk_bf16(o[dt][0] * inv, o[dt][1] * inv); w.y = cvt_pk_bf16(o[dt][2] * inv, o[dt][3] * inv);
        *(u32x2*)(orow + dt * 16 + g4 * 4) = w; }
}
#define LDS_SYNC_ALL() do { asm volatile("s_waitcnt vmcnt(0) lgkmcnt(0)" ::: "memory"); __syncthreads(); } while (0)
__device__ __forceinline__ void ctx_block_unit(int id, const bf16* QKV, const bf16* VTP, bf16* Z, LAS unsigned char* lds, int wave, int lane) {
    const int bh = id >> 1, b = bh >> 3, hh = bh & 7, qt = (id & 1) * 8 + wave, l16 = lane & 15, g4 = lane >> 4;
    const int tq = b * 256 + qt * 16 + l16;
    const bf16* qrow = QKV + (size_t)tq * QP + hh * 64;
    const bf16x8 qf0 = *(const bf16x8*)(qrow + g4 * 8), qf1 = *(const bf16x8*)(qrow + 32 + g4 * 8);
    stage_k(lds, QKV + (size_t)(b * 256) * QP + 512 + hh * 64, QP, 256, wave, lane);
    stage_v(lds + 32768, VTP + (size_t)(bh * 64) * VPP, VPP, 256, 528, wave, lane);
    LDS_SYNC_ALL();
    f32x4 s[16], o[4];
    const float mx = qk_lds<false, 32>(qf0, qf1, lds, 0, s, (const LAS float*)nullptr, 0, 0, 0, 0, lane);
    const float sum = pv_lds<32, 528>(lds + 32768, 0, s, mx, o, lane);
    attn_store(Z + (size_t)tq * D + hh * 64, o, sum, lane);
    LDS_SYNC_ALL();
}
__device__ __forceinline__ void na_block_unit(int id, const bf16* QKV, const bf16* VTS, const bf16* KC, const bf16* VTC, const LAS float* rpb_l, bf16* Z, LAS unsigned char* lds, int wave, int lane) {
    const int bh = id >> 4, rp = id & 15, b = bh >> 3, hh = bh & 7, r = 2 * rp + (wave >> 2), cb = wave & 3, l16 = lane & 15, g4 = lane >> 4;
    int r0 = r - 4; r0 = r0 < 0 ? 0 : (r0 > 24 ? 24 : r0);
    int r0a = 2 * rp - 4; r0a = r0a < 0 ? 0 : (r0a > 24 ? 24 : r0a);
    int s0 = cb * 16 - 8; s0 = s0 < 0 ? 0 : (s0 > 32 ? 32 : s0);
    const int nrows = (32 - r0a) < 9 ? (32 - r0a) : 9;
    const int tb = NP + b * 2048, tq = tb + r * 64 + cb * 16 + l16;
    const bf16* qrow = QKV + (size_t)tq * QP + hh * 64;
    const bf16x8 qf0 = *(const bf16x8*)(qrow + g4 * 8), qf1 = *(const bf16x8*)(qrow + 32 + g4 * 8);
    const int kwin = (r0 - r0a) * 64 + s0;
    stage_k(lds, QKV + (size_t)(tb + r0a * 64) * QP + 512 + hh * 64, QP, nrows * 64, wave, lane);
    LDS_SYNC_ALL();
    f32x4 s[16], o[4];
    const float m1 = qk_lds<true, 64>(qf0, qf1, lds, kwin, s, rpb_l + hh * 465, r, r0, s0, cb, lane);
    LDS_SYNC_ALL();
    stage_v(lds, VTS + (size_t)(bh * 64) * VSP + r0a * 64, VSP, nrows * 64, 1168, wave, lane);
    LDS_SYNC_ALL();
    float sum = pv_lds<64, 1168>(lds, kwin, s, m1, o, lane);
    LDS_SYNC_ALL();
    stage_k(lds, KC + (size_t)bh * 256 * 64, 64, 256, wave, lane);
    stage_v(lds + 32768, VTC + (size_t)bh * 64 * VPP, VPP, 256, 528, wave, lane);
    LDS_SYNC_ALL();
    f32x4 o2[4];
    const float m2 = qk_lds<false, 32>(qf0, qf1, lds, 0, s, (const LAS float*)nullptr, 0, 0, 0, 0, lane);
    const float sum2 = pv_lds<32, 528>(lds + 32768, 0, s, m2, o2, lane);
    const float mm = fmaxf(m1, m2), wa = __builtin_amdgcn_exp2f(m1 - mm), wb = __builtin_amdgcn_exp2f(m2 - mm);
    sum = sum * wa + sum2 * wb;
#pragma unroll
    for (int dt = 0; dt < 4; ++dt) o[dt] = o[dt] * wa + o2[dt] * wb;
    attn_store(Z + (size_t)tq * D + hh * 64, o, sum, lane);
    LDS_SYNC_ALL();
}

__device__ __forceinline__ const float* ldp(const unsigned long long* tab, int k) {
    const unsigned long long v = __hip_atomic_load(tab + k, __ATOMIC_RELAXED, __HIP_MEMORY_SCOPE_WORKGROUP);
    const unsigned lo = __builtin_amdgcn_readfirstlane((unsigned)v), hi = __builtin_amdgcn_readfirstlane((unsigned)(v >> 32));
    return (const float*)(((unsigned long long)hi << 32) | lo);
}

#define XB_TMO      128
#define XB_XCNT(j)  (256  + 64 * (j))
#define XB_XSUB(j)  (1280 + 64 * (j))
#define XB_XGEN(j)  (2304 + 64 * (j))
#define XB_TOP      3328
#define XB_TOPGEN   3392
#define XCD_BAR_WORDS 3456
#define XB_SPIN_CAP (1u << 18)
__device__ __forceinline__ unsigned xb_ld(unsigned* p)              { return __hip_atomic_load(p, __ATOMIC_RELAXED, __HIP_MEMORY_SCOPE_AGENT); }
__device__ __forceinline__ unsigned xb_add(unsigned* p, unsigned v) { return __hip_atomic_fetch_add(p, v, __ATOMIC_RELAXED, __HIP_MEMORY_SCOPE_AGENT); }
__device__ __forceinline__ unsigned xb_xcc_id() { return (unsigned)__builtin_amdgcn_s_getreg((3 << 11) | 20) & 0xFu; }
#define XB_SPIN(cond, bar) do { unsigned _sp = 0; while (cond) { __builtin_amdgcn_s_sleep(1); \
    if ((++_sp & 255u) == 0u) { if (xb_ld(&(bar)[XB_TMO])) break; if (_sp > XB_SPIN_CAP) { atomicAdd(&(bar)[XB_TMO], 1u); break; } } } } while (0)
struct XcdBarrier { unsigned* bar; unsigned x; volatile LAS unsigned* st; };
__device__ __forceinline__ XcdBarrier xcd_barrier_post(unsigned* bar, volatile LAS unsigned* st) {
    XcdBarrier b; b.bar = bar; b.x = xb_xcc_id(); b.st = st;
    if (threadIdx.x == 0) (void)xb_add(&bar[XB_XCNT(b.x)], 1u);
    return b;
}
__device__ __forceinline__ void xcd_barrier_complete(unsigned* bar, unsigned x, unsigned& nloc, unsigned& nx) {
    const unsigned G = gridDim.x * gridDim.y * gridDim.z;
    unsigned sum, cnt, mine, sp = 0u;
    for (;;) {
        sum = 0u; cnt = 0u; mine = 0u;
#pragma unroll
        for (unsigned j = 0; j < 16; ++j) { const unsigned c = xb_ld(&bar[XB_XCNT(j)]); sum += c; cnt += (c > 0u) ? 1u : 0u; mine = (j == x) ? c : mine; }
        if (sum == G) break;
        __builtin_amdgcn_s_sleep(1);
        if ((++sp & 255u) == 0u) { if (xb_ld(&bar[XB_TMO])) break; if (sp > XB_SPIN_CAP) { atomicAdd(&bar[XB_TMO], 1u); break; } }
    }
    nloc = mine > 0u ? mine : 1u; nx = cnt > 0u ? cnt : 1u;
}
__device__ __forceinline__ void xcd_barrier(const XcdBarrier& b) {
    asm volatile("s_waitcnt vmcnt(0)" ::: "memory");
    __syncthreads();
    if (threadIdx.x == 0) {
        unsigned* bar = b.bar;
        __builtin_amdgcn_s_waitcnt(0);
        unsigned nloc = b.st[0], nx = b.st[1];
        if (nloc == 0u) { xcd_barrier_complete(bar, b.x, nloc, nx); b.st[0] = nloc; b.st[1] = nx; }
        const unsigned old = xb_add(&bar[XB_XSUB(b.x)], 1u);
        const unsigned gen = old / nloc;
        if (old + 1u == (gen + 1u) * nloc) {
            __builtin_amdgcn_fence(__ATOMIC_RELEASE, "agent");
            asm volatile("s_waitcnt vmcnt(0)" ::: "memory");
            const unsigned og = xb_add(&bar[XB_TOP], 1u);
            const unsigned tg = og / nx;
            if (og + 1u == (tg + 1u) * nx) xb_add(&bar[XB_TOPGEN], 1u);
            else XB_SPIN(xb_ld(&bar[XB_TOPGEN]) == tg, bar);
            __builtin_amdgcn_fence(__ATOMIC_ACQUIRE, "agent");
            xb_add(&bar[XB_XGEN(b.x)], 1u);
            asm volatile("s_waitcnt vmcnt(0)" ::: "memory");
        } else {
            XB_SPIN(xb_ld(&bar[XB_XGEN(b.x)]) == gen, bar);
            __builtin_amdgcn_fence(__ATOMIC_ACQUIRE, "agent");
            asm volatile("s_waitcnt vmcnt(0)" ::: "memory");
        }
    }
    __syncthreads();
}
struct Args { const float* in[33]; float* out; unsigned char* ws; int ph_lo, ph_hi; };

__global__ void __launch_bounds__(NTHR) fwd_megakernel(Args args) {
    extern __shared__ __attribute__((aligned(16))) unsigned char lds_raw[];
    LAS unsigned char* lds = (LAS unsigned char*)lds_raw;
    cg::grid_group grid = cg::this_grid();
    const int wave = __builtin_amdgcn_readfirstlane((int)threadIdx.x >> 6);
    const int G = gridDim.x, bx = blockIdx.x;
    const int vcu = (G % 8 == 0) ? (bx % 8) * (G / 8) + bx / 8 : bx;
    const int gw = vcu * NWAVES + wave, NGW = G * NWAVES;
    const int NGT = G * NTHR;
#define PHASE_IDS const int lane = lane_id(), tid = wave * 64 + lane, gtid = vcu * NTHR + tid; (void)gtid; (void)tid;
    unsigned char* ws = args.ws;
    float* out = args.out;
    unsigned long long* tab = (unsigned long long*)(ws + WS_TAB) + (size_t)blockIdx.x * 64;
    if (threadIdx.x == 0) {
#pragma unroll
        for (int k = 0; k < 33; ++k) tab[k] = (unsigned long long)args.in[k];
    }
    { const float* rp_ = args.in[20]; LAS float* rl_ = (LAS float*)(lds + LDS_RPB); for (int i = threadIdx.x; i < 8 * 465; i += NTHR) rl_[i] = rp_[i]; }
    volatile LAS unsigned* bst = (volatile LAS unsigned*)(lds + 131072);
    if (threadIdx.x < 8) bst[threadIdx.x] = 0u;
    asm volatile("s_waitcnt vmcnt(0) lgkmcnt(0)" ::: "memory");
    __syncthreads();
    XcdBarrier xbar; xbar.bar = (unsigned*)(ws + WS_BAR); xbar.x = 0; xbar.st = bst;
    if (args.ph_hi - args.ph_lo > 1) xbar = xcd_barrier_post((unsigned*)(ws + WS_BAR), bst);
    if (args.ph_hi > 1000) grid.sync();
    float* MODS = (float*)(ws + WS_MODS); f32x2* LPOW = (f32x2*)(ws + WS_LPOW); f32x2* BBAR = (f32x2*)(ws + WS_BBAR); float* KTAB = (float*)(ws + WS_KTAB);
    bf16* KC = (bf16*)(ws + WS_KC); bf16* VTC = (bf16*)(ws + WS_VTC);
    bf16* WIN0 = (bf16*)(ws + WS_WIN0); bf16* WOUT0 = (bf16*)(ws + WS_WOUT0); bf16* W1_0 = (bf16*)(ws + WS_W1_0); bf16* W2_0 = (bf16*)(ws + WS_W2_0);
    bf16* WIN1 = (bf16*)(ws + WS_WIN1); bf16* WOUT1 = (bf16*)(ws + WS_WOUT1); bf16* W1_1 = (bf16*)(ws + WS_W1_1); bf16* W2_1 = (bf16*)(ws + WS_W2_1);
    bf16* GLUT = (bf16*)(ws + WS_GLUT); bf16* BMAT = (bf16*)(ws + WS_BMAT); bf16* FMAT = (bf16*)(ws + WS_FMAT);
    bf16* H = (bf16*)(ws + WS_H); float* FBUF = (float*)(ws + WS_H);
    bf16* HID = (bf16*)(ws + WS_R); bf16* PROJ0 = (bf16*)(ws + WS_R); bf16* QKV = (bf16*)(ws + WS_R);
    bf16* Z = (bf16*)(ws + WS_Z); bf16* ABUF = (bf16*)(ws + WS_ABUF); bf16* YBUF = (bf16*)(ws + WS_YBUF);
    bf16* VTP = (bf16*)(ws + WS_VTP); bf16* VTS = (bf16*)(ws + WS_VTS);
    float* XBUF = (float*)(ws + WS_XBUF); unsigned* PCNT = (unsigned*)(ws + WS_BAR) + CNT_OFF_WORDS;
    float* X = out;

    const int lo = args.ph_lo, hi = args.ph_hi;
#ifndef PHMASK
#define PHMASK 0x7ffff
#endif
#define IN(k) (((PHMASK >> (k)) & 1) && lo <= (k) && (k) < hi)
#ifndef REPMASK
#define REPMASK 0
#endif
#define REP(k) for (int rep_ = 0; rep_ < (((REPMASK >> (k)) & 1) + 1); ++rep_)
#define SEAM2(k, k2) do { if (IN(k) && IN(k2)) xcd_barrier(xbar); } while (0)
#define SEAM(k) do { if (IN(k) && IN((k) + 1)) xcd_barrier(xbar); } while (0)

    if (IN(0)) REP(0) { PHASE_IDS
        const float* ab_w_in = ldp(tab, 14);
        const float* ab_w_out = ldp(tab, 18);
        const float* mlp_w1 = ldp(tab, 12);
        const float* mlp_w2 = ldp(tab, 13);
        LAS float* scr = (LAS float*)(lds + wave * 16384);
        constexpr int I0 = 1024, I1 = I0 + 256, I2 = I1 + 2048, I3 = I2 + 2048;
        for (int it = gw; it < I3; it += NGW) {
            if (it < I0) tr_item(ab_w_in, 2048, WIN0, 1024, scr, it, lane);
            else if (it < I1) tr_item(ab_w_out + (size_t)512 * 1024, 1024, WOUT0 + 512, 1024, scr, it - I0, lane);
            else if (it < I2) tr_item(mlp_w1, 4096, W1_0, 1024, scr, it - I1, lane);
            else tr_item(mlp_w2, 1024, W2_0, 4096, scr, it - I2, lane);
        }
        __syncthreads();
        {
            const float* ada_w = ldp(tab, 10); const float* ada_b = ldp(tab, 11); const float* cvec = ldp(tab, 2); const float* c_ctx = ldp(tab, 7);
            LAS float* sl = (LAS float*)lds;
            LAS float* red = (LAS float*)(lds + 32768);
            if (vcu < 192) {
                for (int i = tid; i < 5 * 1024; i += NTHR) { const float c = i < 4096 ? cvec[i] : c_ctx[i - 4096]; sl[i] = c * sigmoidf_(c); }
                __syncthreads();
                for (int it = vcu; it < 192; it += G) {
                    const int layer = it / 96, n = (it % 96) * 64 + (tid & 63), kc = tid >> 6;
                    const float* w = ada_w + (size_t)layer * 1024 * 6144 + (size_t)(kc * 128) * 6144 + n;
                    float a0 = 0.f, a1 = 0.f, a2 = 0.f, a3 = 0.f, a4 = 0.f;
#pragma unroll 32
                    for (int k = 0; k < 128; ++k) {
                        const int kk = kc * 128 + k; const float wv = w[(size_t)k * 6144];
                        a0 += sl[kk] * wv; a1 += sl[1024 + kk] * wv; a2 += sl[2048 + kk] * wv; a3 += sl[3072 + kk] * wv; a4 += sl[4096 + kk] * wv;
                    }
                    red[(kc * 5 + 0) * 64 + (tid & 63)] = a0; red[(kc * 5 + 1) * 64 + (tid & 63)] = a1; red[(kc * 5 + 2) * 64 + (tid & 63)] = a2;
                    red[(kc * 5 + 3) * 64 + (tid & 63)] = a3; red[(kc * 5 + 4) * 64 + (tid & 63)] = a4;
                    __syncthreads();
                    if (tid < 320) { const int cnd = tid >> 6, col = tid & 63; float s = 0.f;
#pragma unroll
                        for (int q = 0; q < 8; ++q) s += red[(q * 5 + cnd) * 64 + col];
                        const int nn = (it % 96) * 64 + col;
                        MODS[(layer * 5 + cnd) * 6144 + nn] = s + ada_b[layer * 6144 + nn]; }
                    __syncthreads();
                }
            }
        }
        {
            const float* log_step = ldp(tab, 23); const float* lam_re = ldp(tab, 21); const float* lam_im = ldp(tab, 22);
            const float* ssm_b_re = ldp(tab, 24); const float* ssm_b_im = ldp(tab, 25);
            for (int i = gtid; i < 2 * 32 * 17 * 64; i += NGT) {
                const int p = i & 63, d = (i >> 6) % 17, dg = i / (64 * 17);
                const float st = fast_exp(log_step[dg]);
                LPOW[i] = lam_pow(lam_re[dg * 64 + p], lam_im[dg * 64 + p], st, d);
            }
            for (int i = gtid; i < 2 * 32 * 64 * 16; i += NGT) {
                const int dgp = i >> 4, dg = dgp >> 6;
                const float st = fast_exp(log_step[dg]);
                const f32x2 lam = (f32x2){lam_re[dgp], lam_im[dgp]};
                const f32x2 z = lam * st;
                f32x2 phi;
                if (z.x * z.x + z.y * z.y < 0.25f) {
                    f32x2 acc = (f32x2){1.f, 0.f};
#pragma unroll
                    for (int n = 12; n >= 2; --n) { acc = cmul(acc, z) * (1.0f / (float)n); acc.x += 1.0f; }
                    phi = acc * st;
                } else {
                    const f32x2 L = lam_pow(lam.x, lam.y, st, 1);
                    const f32x2 num = (f32x2){L.x - 1.0f, L.y}; const float den = 1.0f / (lam.x * lam.x + lam.y * lam.y);
                    phi = (f32x2){(num.x * lam.x + num.y * lam.y) * den, (num.y * lam.x - num.x * lam.y) * den};
                }
                BBAR[i] = cmul(phi, (f32x2){ssm_b_re[i], ssm_b_im[i]});
            }
        }
        {
            const float* pool_w = ldp(tab, 15); const float* pool_scale = ldp(tab, 16);
            for (int i = gtid; i < 128 * 1024; i += NGT) { const int n = i & 1023, k0 = (i >> 10) * 4, gq = k0 >> 7, c = k0 & 127;
                const float* pw = pool_w + ((size_t)gq * 128 + c) * 128; const float* ps = pool_scale + gq * 128; const float* wo = ab_w_out + (size_t)(gq * 128) * 1024 + n;
                float a0 = 0.f, a1 = 0.f, a2 = 0.f, a3 = 0.f;
#pragma unroll 32
                for (int d = 0; d < 128; ++d) { const float wv = ps[d] * wo[(size_t)d * 1024]; a0 += pw[d] * wv; a1 += pw[128 + d] * wv; a2 += pw[256 + d] * wv; a3 += pw[384 + d] * wv; }
                u32x2 w; w.x = cvt_pk_bf16(a0, a1); w.y = cvt_pk_bf16(a2, a3);
                *(u32x2*)(WOUT0 + (size_t)n * 1024 + k0) = w; }
        }
    }
    SEAM(0);

    if (IN(1)) REP(1) { PHASE_IDS
        const float* x_prompt = ldp(tab, 0);
        const float* x_sample = ldp(tab, 1);
        const float* norm1_g = ldp(tab, 8);
        rms_mod_rows(x_prompt, x_sample - (size_t)NP * D, H, norm1_g, MODS, 0, gw, NGW, lane);
    }
    SEAM(1);

    if (IN(2)) REP(2) {
        pg8::Gemm g{H, WIN0, 1024, 1024, 1024}; pg8::Sched S; S.init(48, 8, G, bx, 0);
        pg8::EpiStore<0> E{PROJ0, 2048};
        pg8::gemm_phase(lds, wave, g, S, E);
        if (bx >= 128) {
            const float* ssm_c_re = ldp(tab, 26); const float* ssm_c_im = ldp(tab, 27);
            const int sid = (bx - 128) * NTHR + wave * 64 + lane_id();
            if (sid < 64 * 256) {
                const int gi = sid & 15, go = (sid >> 4) & 15, dg = sid >> 8;
                const float* cr = ssm_c_re + ((size_t)dg * 16 + go) * 64; const float* ci = ssm_c_im + ((size_t)dg * 16 + go) * 64;
                const f32x2* lp = LPOW + ((size_t)dg * 17 + 1) * 64; const f32x2* bb = BBAR + (size_t)dg * 64 * 16 + gi;
                float a[16];
#pragma unroll
                for (int d = 0; d < 16; ++d) a[d] = 0.f;
#pragma unroll 2
                for (int p = 0; p < 64; ++p) { f32x2 v = cmul((f32x2){cr[p], ci[p]}, bb[p * 16]); const f32x2 L = lp[p];
#pragma unroll
                    for (int d = 0; d < 16; ++d) { a[d] += v.x; v = cmul(v, L); } }
#pragma unroll
                for (int d = 0; d < 16; ++d) KTAB[(((size_t)dg * 16 + d) * 16 + go) * 16 + gi] = a[d];
            }
        }
    }
    SEAM(2);

    if (IN(3)) REP(3) { PHASE_IDS
        const float* conv_w = ldp(tab, 17);

        for (int it = gtid; it < NTOK * 128; it += NGT) {
            int r, cv;
            if (it < NTOK * 64) { const int gq = it / (NTOK * 16), rem = it - gq * (NTOK * 16); r = rem >> 4; cv = gq * 16 + (rem & 15); }
            else { const int i2 = it - NTOK * 64; r = i2 >> 6; cv = 64 + (i2 & 63); }
            int sb, T, t;
            if (r < NP) { sb = r & ~255; T = 256; t = r & 255; } else { const int rs = r - NP; sb = NP + (rs & ~2047); T = 2048; t = rs & 2047; }
            float o[8];
            if (cv < 64) {
                const int gq = cv >> 4, hw = 1 << gq; const int l0 = t - hw < 0 ? 0 : t - hw, h1 = t + hw > T ? T : t + hw;
                float a[8];
#pragma unroll
                for (int q = 0; q < 8; ++q) a[q] = 0.f;
                const bf16* pb = PROJ0 + (size_t)sb * 2048 + cv * 8;
#define POOL_WIN(HW) { u32x4 w_[2 * HW]; _Pragma("unroll") for (int k = 0; k < 2 * HW; ++k) { int tt = t - HW + k; const bool ok = tt >= l0 && tt < h1; tt = ok ? tt : t; w_[k] = *(const u32x4*)(pb + (size_t)tt * 2048); if (!ok) w_[k] = (u32x4){0u, 0u, 0u, 0u}; } \
                    _Pragma("unroll") for (int k = 0; k < 2 * HW; ++k) { float f[8]; unpack8(w_[k], f); _Pragma("unroll") for (int q = 0; q < 8; ++q) a[q] += f[q]; } }
                if (gq == 0) POOL_WIN(1) else if (gq == 1) POOL_WIN(2) else if (gq == 2) POOL_WIN(4) else POOL_WIN(8)
#undef POOL_WIN
                float sf[8]; unpack8(*(const u32x4*)(pb + (size_t)t * 2048), sf);
                const float ic = 1.0f / (float)(h1 - l0);
#pragma unroll
                for (int q = 0; q < 8; ++q) o[q] = a[q] * ic - sf[q];
                *(u32x4*)(Z + (size_t)r * D + cv * 8) = pack8(o);
            } else {
                const int ch0 = (cv - 64) * 8;
                float bg[8]; unpack8(*(const u32x4*)(PROJ0 + (size_t)r * 2048 + 512 + ch0), bg);
#pragma unroll
                for (int q = 0; q < 8; ++q) o[q] = 0.f;
#pragma unroll
                for (int j = 0; j < 3; ++j) { const int tt = t + j - 1;
                    if (tt >= 0 && tt < T) { float cg8[8], vv[8]; const bf16* pr = PROJ0 + (size_t)(sb + tt) * 2048 + ch0;
                        unpack8(*(const u32x4*)(pr + 1024), cg8); unpack8(*(const u32x4*)(pr + 1536), vv);
                        const f32x4 w0 = *(const f32x4*)(conv_w + j * 512 + ch0), w1 = *(const f32x4*)(conv_w + j * 512 + ch0 + 4);
#pragma unroll
                        for (int q = 0; q < 4; ++q) { o[q] += w0[q] * cg8[q] * vv[q]; o[q + 4] += w1[q] * cg8[q + 4] * vv[q + 4]; } } }
#pragma unroll
                for (int q = 0; q < 8; ++q) o[q] *= bg[q];
                *(u32x4*)(Z + (size_t)r * D + 512 + ch0) = pack8(o);
            }
        }
    }
    SEAM(3);

    if (IN(4)) REP(4) {
        const float* x_prompt = ldp(tab, 0);
        const float* x_sample = ldp(tab, 1);

        pg8::Gemm g{Z, WOUT0, 1024, 1024, 1024}; pg8::Sched S; S.init(48, 4, G, bx, 3);
        pg8::EpiResGateNorm E{x_prompt, x_sample, X, MODS + 2 * 1024, ldp(tab, 9), MODS, 3, H, XBUF, PCNT + 0 * 48 * 64, lds + LDS_XOFF};
        pg8::gemm_phase(lds, wave, g, S, E);
    }
    SEAM2(4, 6);
    if (IN(6)) REP(6) {
        pg8::Gemm g{H, W1_0, 1024, 1024, 1024}; pg8::Sched S; S.init(48, 16, G, bx, 0);
        pg8::EpiStore<1> E{HID, 4096};
        pg8::gemm_phase(lds, wave, g, S, E);
    }
    SEAM(6);
    if (IN(7)) REP(7) {
        pg8::Gemm g{HID, W2_0, 4096, 4096, 4096}; pg8::Sched S; S.init(48, 4, G, bx, 3);
        pg8::EpiResGateNorm E{nullptr, nullptr, X, MODS + 5 * 1024, ldp(tab, 8) + 1024, MODS + 5 * 6144, 0, H, XBUF + (size_t)1 * NTOK * 4, PCNT + 1 * 48 * 64, lds + LDS_XOFF};
        pg8::gemm_phase(lds, wave, g, S, E);
        if (bx >= 192) {
            const float* mlp_w1 = ldp(tab, 12); const float* mlp_w2 = ldp(tab, 13); const float* cd_w_in = ldp(tab, 19); const float* cd_w_out = ldp(tab, 31); const float* glu_w = ldp(tab, 29);
            LAS float* scr = (LAS float*)(lds + wave * 16384); const int lane = lane_id();
            constexpr int J0 = 1024, J1 = J0 + 512, J2 = J1 + 128;
            for (int it = (bx - 192) * NWAVES + wave; it < J2; it += 64 * NWAVES) {
                if (it < J0) tr_item(cd_w_in, 2048, WIN1, 1024, scr, it, lane);
                else if (it < J1) tr_item(cd_w_out, 1024, WOUT1, 1024, scr, it - J0, lane);
                else tr_item(glu_w, 512, GLUT, 512, scr, it - J1, lane);
            }
            const float* ssm_c_re = ldp(tab, 26); const float* ssm_c_im = ldp(tab, 27); const float* ssm_d = ldp(tab, 28);
            const int sid = (bx - 192) * NTHR + wave * 64 + lane;
#pragma unroll 4
            for (int i = sid; i < 32 * 256 * 128; i += 64 * NTHR) {
                const int k = (i & 127) * 2, n = (i >> 7) & 255, gg = i >> 15, j = k >> 4, gi = k & 15, dir = n >> 7, p = (n & 127) >> 1, ri = n & 1;
                const int dg = dir * 32 + gg, e = dir == 0 ? 15 - j : j;
                const f32x2 L = LPOW[((size_t)dg * 17 + e) * 64 + p];
                const f32x2 v0 = cmul(L, BBAR[((size_t)dg * 64 + p) * 16 + gi]), v1 = cmul(L, BBAR[((size_t)dg * 64 + p) * 16 + gi + 1]);
                *(unsigned*)(FMAT + ((size_t)gg * 256 + n) * 512 + k) = cvt_pk_bf16(ri ? v0.y : v0.x, ri ? v1.y : v1.x);
            }
#pragma unroll 4
            for (int i = sid; i < 32 * 256 * 128; i += 64 * NTHR) {
                const int kk = (i & 127) * 2, n = (i >> 7) & 255, gg = i >> 15, t = n >> 4, go = n & 15, dir = kk >> 7, p = (kk & 127) >> 1;
                const int dg = dir * 32 + gg, e = dir == 0 ? t + 1 : 16 - t;
                const size_t ci = ((size_t)dg * 16 + go) * 64 + p;
                const f32x2 v = cmul((f32x2){ssm_c_re[ci], ssm_c_im[ci]}, LPOW[((size_t)dg * 17 + e) * 64 + p]);
                *(unsigned*)(BMAT + ((size_t)gg * 256 + n) * 512 + 256 + kk) = cvt_pk_bf16(v.x, -v.y);
            }
#pragma unroll 4
            for (int i = sid; i < 32 * 256 * 128; i += 64 * NTHR) {
                const int k = (i & 127) * 2, n = (i >> 7) & 255, gg = i >> 15, j = k >> 4, gi = k & 15, t = n >> 4, go = n & 15;
                float v0 = 0.f, v1 = 0.f;
                if (t >= j) { const float* kt = KTAB + (((size_t)(0 * 32 + gg) * 16 + (t - j)) * 16 + go) * 16 + gi; v0 += kt[0]; v1 += kt[1]; }
                if (j >= t) { const float* kt = KTAB + (((size_t)(1 * 32 + gg) * 16 + (j - t)) * 16 + go) * 16 + gi; v0 += kt[0]; v1 += kt[1]; }
                if (j == t) { const float dd = ssm_d[gg * 16 + go]; if (go == gi) v0 += dd; if (go == gi + 1) v1 += dd; }
                *(unsigned*)(BMAT + ((size_t)gg * 256 + n) * 512 + k) = cvt_pk_bf16(v0, v1);
            }
            {
                const float* cache_k = ldp(tab, 3); const float* cache_v = ldp(tab, 4);
                for (int i = sid; i < 4 * 8 * 256 * 64 / 2; i += 64 * NTHR) { const f32x2 v = *(const f32x2*)(cache_k + 2 * (size_t)i); ((unsigned*)KC)[i] = cvt_pk_bf16(v.x, v.y); }
                for (int i = sid; i < 4 * 8 * 64 * 256 / 2; i += 64 * NTHR) { const int d = i & 63, l2 = (i >> 6) & 127, bh = i >> 13;
                    const float a = cache_v[((size_t)bh * 256 + 2 * l2) * 64 + d], b = cache_v[((size_t)bh * 256 + 2 * l2 + 1) * 64 + d];
                    *(unsigned*)(VTC + ((size_t)(bh * 64 + d)) * VPP + 2 * l2) = cvt_pk_bf16(a, b); }
            }
        }
    }
    SEAM2(7, 9);
    if (IN(9)) REP(9) {
        { pg8::Gemm g{H, WIN1, 1024, 1024, 1024}; pg8::Sched S; S.init(48, 6, G, bx, 1);
          pg8::EpiProj1 E{QKV, ABUF, out + O_K};
          pg8::gemm_phase(lds, wave, g, S, E); }
        { pg8::Gemm g{WIN1 + (size_t)1024 * 1024, H, 1024, 1024, 1024}; pg8::Sched S; S.init(2, 48, G, (bx + G - 32) % G, 0);
          pg8::EpiVT E{VTP, VTS, out + O_V};
          pg8::gemm_phase(lds, wave, g, S, E); }
        if (bx >= 128) {
            const float* mlp_w1 = ldp(tab, 12); const float* mlp_w2 = ldp(tab, 13);
            LAS float* scr = (LAS float*)(lds + wave * 16384); const int lane = lane_id();
            for (int it = (bx - 128) * NWAVES + wave; it < 4096; it += 128 * NWAVES) {
                if (it < 2048) tr_item(mlp_w1 + (size_t)1024 * 4096, 4096, W1_1, 1024, scr, it, lane);
                else tr_item(mlp_w2 + (size_t)4096 * 1024, 1024, W2_1, 4096, scr, it - 2048, lane);
            }
        }
    }
    SEAM2(9, 12);

#define ATTN_QUEUE(pi, jb, jn) do { \
    const int xq_ = (int)(xb_xcc_id() & 7u); unsigned* ctr_ = QCTR + ((pi) * 8 + xq_) * 16; \
    volatile LAS unsigned* qw_ = (volatile LAS unsigned*)(lds + 131072 + 64); \
    for (;;) { \
        __syncthreads(); \
        if (threadIdx.x == 0) qw_[0] = __hip_atomic_fetch_add(ctr_, 8u, __ATOMIC_RELAXED, __HIP_MEMORY_SCOPE_AGENT); \
        __syncthreads(); \
        const int f_ = (int)qw_[0]; \
        if (f_ >= (jn)) break; \
        const int j_ = (jb) + f_ + wave; \
        if (f_ + wave < (jn)) { \
        const int id = j_ < 256 ? xq_ * 256 + j_ : 2048 + xq_ * 512 + (j_ - 256); \
        const int ll = lane_id(); \
        const int l16 = ll & 15; \
        if (id < 2048) { \
            const int bh = id >> 4, qt = id & 15, b = bh >> 3, hh = bh & 7; \
            const int tq = b * 256 + qt * 16 + l16; \
            attn_unit<false>(QKV + (size_t)tq * QP + hh * 64, QKV + (size_t)(b * 256) * QP + 512 + hh * 64, VTP + (size_t)(bh * 64) * VPP, \
                             nullptr, nullptr, (const LAS float*)nullptr, 0, 0, 0, 0, Z + (size_t)tq * D + hh * 64, ll, lds + wave * 16384); \
        } else { \
            const int i2 = id - 2048, cb = i2 & 3, r = (i2 >> 2) & 31, bh = i2 >> 7, b = bh >> 3, hh = bh & 7; \
            int r0 = r - 4; r0 = r0 < 0 ? 0 : (r0 > 24 ? 24 : r0); \
            int s0 = cb * 16 - 8; s0 = s0 < 0 ? 0 : (s0 > 32 ? 32 : s0); \
            const int tb = NP + b * 2048, tq = tb + r * 64 + cb * 16 + l16; \
            attn_unit<true>(QKV + (size_t)tq * QP + hh * 64, QKV + (size_t)(tb + r0 * 64 + s0) * QP + 512 + hh * 64, \
                            VTS + (size_t)(bh * 64) * VSP + r0 * 64 + s0, KC + (size_t)bh * 256 * 64, VTC + (size_t)bh * 64 * VPP, \
                            rpb_l + hh * 465, r, r0, s0, cb, Z + (size_t)tq * D + hh * 64, ll, lds + wave * 16384); \
        } } \
    } } while (0)
    constexpr int AQ0 = 368, AQ1 = 184, AQ2 = 768 - AQ0 - AQ1;
    unsigned* QCTR = (unsigned*)(ws + WS_BAR) + 3584;
    const LAS float* rpb_l = (const LAS float*)(lds + LDS_RPB);
    if (IN(12)) REP(12) {
        { int kf = 256; asm volatile("" : "+s"(kf)); pg8::Gemm g{ABUF, FMAT, 512, 512, kf}; pg8::Sched S; S.init(96, 1, G, bx, 2);
          pg8::EpiF E{FBUF};
          pg8::gemm_phase(lds, wave, g, S, E); }
        asm volatile("s_waitcnt vmcnt(0)" ::: "memory");
        __syncthreads();
        if (bx < 96) {
            const float* st_re = ldp(tab, 5); const float* st_im = ldp(tab, 6);
            const int gg = bx / 3, ui = bx % 3, tid = wave * 64 + lane_id();
            const int nseq = ui == 0 ? 2048 : 256;
            for (int sq = tid; sq < nseq; sq += NTHR) {
                const int p = sq & 63, dir = (sq >> 6) & 1, bb = ui == 0 ? (sq >> 7) : 16 + (ui - 1) * 2 + (sq >> 7);
            const int nch = bb < 16 ? 16 : 128, cb0 = bb < 16 ? bb * 16 : 256 + (bb - 16) * 128;
            const f32x2 L16 = LPOW[((size_t)(dir * 32 + gg) * 17 + 16) * 64 + p];
            f32x2 S = (f32x2){0.f, 0.f};
            if (bb >= 16) { const size_t si = ((size_t)((bb - 16) * 2 + dir) * 32 + gg) * 64 + p; S = (f32x2){st_re[si], st_im[si]}; }
            f32x2 fa[16], fb[16];
#define SCAN_LOAD(dst, q0) { _Pragma("unroll") for (int u = 0; u < 16; ++u) { const int c = dir == 0 ? (q0) + u : nch - 1 - (q0) - u; dst[u] = *(const f32x2*)(FBUF + ((size_t)gg * 768 + cb0 + c) * 256 + dir * 128 + p * 2); } }
#define SCAN_STEP(src_, q0) { _Pragma("unroll") for (int u = 0; u < 16; ++u) { const int c = dir == 0 ? (q0) + u : nch - 1 - (q0) - u; \
                    ((unsigned*)ABUF)[(((size_t)gg * 768 + cb0 + c) * 512 + 256 + dir * 128 + p * 2) >> 1] = cvt_pk_bf16(S.x, S.y); S = cmul(L16, S) + src_[u]; } }
            SCAN_LOAD(fa, 0);
            for (int q0 = 0; q0 < nch; q0 += 32) {
                if (q0 + 16 < nch) SCAN_LOAD(fb, q0 + 16);
                SCAN_STEP(fa, q0);
                if (q0 + 16 < nch) { if (q0 + 32 < nch) SCAN_LOAD(fa, q0 + 32); SCAN_STEP(fb, q0 + 16); }
            }
#undef SCAN_LOAD
#undef SCAN_STEP
            if (bb < 16) { const size_t oi = ((size_t)(bb * 2 + dir) * 32 + gg) * 64 + p; out[O_SRE + oi] = S.x; out[O_SIM + oi] = S.y; }
            }
            asm volatile("s_waitcnt vmcnt(0)" ::: "memory");
            __syncthreads();
        }
        { pg8::Gemm g{ABUF, BMAT, 512, 512, 512}; pg8::Sched S; S.init(96, 1, G, bx, 2);
          pg8::EpiY E{YBUF};
          pg8::gemm_phase(lds, wave, g, S, E); }
        if (G == 256) {
            if (bx >= 96) {
                ctx_block_unit(vcu, QKV, VTP, Z, lds, wave, lane_id());
                const int jq = ((bx - 96) & 7) * 20 + ((bx - 96) >> 3);
                na_block_unit(2 * jq, QKV, VTS, KC, VTC, rpb_l, Z, lds, wave, lane_id());
                na_block_unit(2 * jq + 1, QKV, VTS, KC, VTC, rpb_l, Z, lds, wave, lane_id());
            }
        } else {
            for (int bu = vcu; bu < 768; bu += G) {
                const int ln = lane_id();
                if (bu < 256) ctx_block_unit(bu, QKV, VTP, Z, lds, wave, ln);
                else na_block_unit(bu - 256, QKV, VTS, KC, VTC, rpb_l, Z, lds, wave, ln);
            }
        }
    }
    SEAM(12);
    if (IN(13)) REP(13) {
        const float* glu_b = ldp(tab, 30);

        pg8::Gemm g{YBUF, GLUT, 512, 512, 512}; pg8::Sched S; S.init(48, 2, G, bx, 0);
        pg8::EpiGLU E{YBUF, Z, glu_b};
        pg8::gemm_phase(lds, wave, g, S, E);
        if (G == 256 && bx >= 96) {
            const int jq = ((bx - 96) & 7) * 20 + ((bx - 96) >> 3);
            na_block_unit(320 + jq, QKV, VTS, KC, VTC, rpb_l, Z, lds, wave, lane_id());
            if (jq < 32) na_block_unit(480 + jq, QKV, VTS, KC, VTC, rpb_l, Z, lds, wave, lane_id());
        }
        if (G == 256 && bx < 96) ctx_block_unit(vcu, QKV, VTP, Z, lds, wave, lane_id());
    }
    SEAM(13);
    if (IN(14)) REP(14) {
        pg8::Gemm g{Z, WOUT1, 1024, 1024, 1024}; pg8::Sched S; S.init(48, 4, G, bx, 3);
        pg8::EpiResGateNorm E{nullptr, nullptr, X, MODS + 5 * 6144 + 2 * 1024, ldp(tab, 9) + 1024, MODS + 5 * 6144, 3, H, XBUF + (size_t)2 * NTOK * 4, PCNT + 2 * 48 * 64, lds + LDS_XOFF};
        pg8::gemm_phase(lds, wave, g, S, E);
    }
    SEAM2(14, 16);
    if (IN(16)) REP(16) {
        pg8::Gemm g{H, W1_1, 1024, 1024, 1024}; pg8::Sched S; S.init(48, 16, G, bx, 0);
        pg8::EpiStore<1> E{HID, 4096};
        pg8::gemm_phase(lds, wave, g, S, E);
    }
    SEAM(16);
    if (IN(17)) REP(17) {
        pg8::Gemm g{HID, W2_1, 4096, 4096, 4096}; pg8::Sched S; S.init(48, 4, G, bx, 3);
        pg8::EpiResGateNorm E{nullptr, nullptr, X, MODS + 5 * 6144 + 5 * 1024, ldp(tab, 32), MODS, 0, nullptr, XBUF + (size_t)3 * NTOK * 4, PCNT + 3 * 48 * 64, lds + LDS_XOFF};
        pg8::gemm_phase(lds, wave, g, S, E);
    }
#undef IN
#undef SEAM
#undef SEAM2
}

extern "C" void kernel_launch(void* const* d_in, const int* in_sizes, int n_in, void* d_out, int out_size, void* d_ws, size_t ws_size, hipStream_t stream) {
    static int grid = 0;
    if (grid == 0) {
        if (n_in != 33 || ws_size < WS_END) { fprintf(stderr, "kernel_launch: unexpected n_in %d / ws_size %zu\n", n_in, ws_size); grid = -1; return; }
        int dev = 0, cus = 0, per_cu = 0;
        hipGetDevice(&dev);
        hipDeviceGetAttribute(&cus, hipDeviceAttributeMultiprocessorCount, dev);
        if (hipFuncSetAttribute((const void*)fwd_megakernel, hipFuncAttributeMaxDynamicSharedMemorySize, LDS_BYTES) != hipSuccess) { fprintf(stderr, "kernel_launch: hipFuncSetAttribute failed\n"); grid = -1; return; }
        if (hipOccupancyMaxActiveBlocksPerMultiprocessor(&per_cu, (const void*)fwd_megakernel, NTHR, LDS_BYTES) != hipSuccess || per_cu < 1) { fprintf(stderr, "kernel_launch: occupancy query gave %d\n", per_cu); per_cu = 1; (void)hipGetLastError(); }
        grid = cus;
        fprintf(stderr, "kernel_launch: cus %d per_cu %d grid %d\n", cus, per_cu, grid);
    }
    if (grid < 0) return;
    Args a{};
    for (int i = 0; i < 33; ++i) a.in[i] = (const float*)d_in[i];
    a.out = (float*)d_out; a.ws = (unsigned char*)d_ws;
#if MK_N_LAUNCHES == 1
    if (hipMemsetAsync((char*)d_ws + WS_BAR, 0, 65536, stream) != hipSuccess) { fprintf(stderr, "kernel_launch: memset of barrier words failed\n"); return; }
    a.ph_lo = 0; a.ph_hi = NPHASES;
    void* kargs[] = {&a};
    hipError_t e = hipLaunchCooperativeKernel((const void*)fwd_megakernel, dim3(grid), dim3(NTHR), kargs, LDS_BYTES, stream);
    if (e != hipSuccess) fprintf(stderr, "cooperative launch failed: %s (grid %d)\n", hipGetErrorString(e), grid);
#else
    for (int ph = 0; ph < NPHASES; ++ph) {
        a.ph_lo = ph; a.ph_hi = ph + 1;
        hipLaunchKernelGGL(fwd_megakernel, dim3(grid), dim3(NTHR), LDS_BYTES, stream, a);
    }
#endif
}
```

```cpp
#include <hip/hip_runtime.h>
#include <hip/hip_cooperative_groups.h>
#include <cstdio>
#include <cstdint>
namespace cg = cooperative_groups;

#ifndef MK_N_LAUNCHES
#define MK_N_LAUNCHES 1
#endif

#define LAS __attribute__((address_space(3)))
typedef unsigned short bf16;
typedef short bf16x8 __attribute__((ext_vector_type(8)));
typedef float f32x4 __attribute__((ext_vector_type(4)));
typedef float f32x2 __attribute__((ext_vector_type(2)));
typedef unsigned u32x4 __attribute__((ext_vector_type(4)));
typedef unsigned u32x2 __attribute__((ext_vector_type(2)));

constexpr int D = 1024, NP = 4096, NS = 8192, NTOK = 12288, FF = 4096;
constexpr int NTHR = 512, NWAVES = 8;
constexpr float EPS = 1e-6f;
constexpr int LDS_BYTES = 131072 + 256 + 8192 + 15360;
constexpr int LDS_XOFF = 131072 + 256, LDS_RPB = LDS_XOFF + 8192;
constexpr int NPHASES = 19;
constexpr int QP = 1664, VPP = 384, VSP = 2176;

constexpr size_t MiB = 1u << 20;
constexpr size_t WS_MODS = 0;
constexpr size_t WS_LPOW = 256 * 1024;
constexpr size_t WS_BBAR = 1 * MiB;
constexpr size_t WS_KTAB = 2 * MiB;
constexpr size_t WS_KC = 3 * MiB;
constexpr size_t WS_VTC = 216 * MiB;
constexpr size_t WS_WIN0 = 5 * MiB, WS_WOUT0 = 9 * MiB, WS_W1_0 = 11 * MiB, WS_W2_0 = 19 * MiB;
constexpr size_t WS_WIN1 = 27 * MiB, WS_WOUT1 = 31 * MiB, WS_W1_1 = 33 * MiB, WS_W2_1 = 41 * MiB;
constexpr size_t WS_GLUT = 49 * MiB;
constexpr size_t WS_BMAT = 50 * MiB;
constexpr size_t WS_FMAT = 58 * MiB;
constexpr size_t WS_H = 66 * MiB;
constexpr size_t WS_R = 90 * MiB;
constexpr size_t WS_Z = WS_R + 48 * MiB;
constexpr size_t WS_ABUF = WS_R + 72 * MiB;
constexpr size_t WS_YBUF = 186 * MiB;
constexpr size_t WS_VTP = 198 * MiB;
constexpr size_t WS_VTS = 204 * MiB;
constexpr size_t WS_TAB = 213 * MiB;
constexpr size_t WS_BAR = 214 * MiB;
constexpr size_t WS_XBUF = 215 * MiB;
constexpr size_t WS_XB = 218 * MiB;
constexpr size_t WS_END = 242 * MiB;
constexpr int CNT_OFF_WORDS = 4096;

constexpr size_t O_K = (size_t)NTOK * D, O_V = O_K + 2097152, O_SRE = O_V + 2097152, O_SIM = O_SRE + 65536;

__device__ __forceinline__ unsigned cvt_pk_bf16(float lo, float hi) { unsigned r; asm volatile("v_cvt_pk_bf16_f32 %0, %1, %2" : "=v"(r) : "v"(lo), "v"(hi)); return r; }
__device__ __forceinline__ float bf_lo(unsigned u) { return __uint_as_float(u << 16); }
__device__ __forceinline__ float bf_hi(unsigned u) { return __uint_as_float(u & 0xffff0000u); }
__device__ __forceinline__ float wave_sum(float v) {
#pragma unroll
    for (int o = 1; o < 64; o <<= 1) v += __shfl_xor(v, o);
    return v;
}
__device__ __forceinline__ int lane_id() { int l; asm volatile("v_mbcnt_lo_u32_b32 %0, -1, 0\n\tv_mbcnt_hi_u32_b32 %0, -1, %0" : "=v"(l)); return l; }
__device__ __forceinline__ float fast_exp(float x) { return __builtin_amdgcn_exp2f(x * 1.44269504089f); }
__device__ __forceinline__ float sigmoidf_(float x) { return 1.0f / (1.0f + fast_exp(-x)); }
__device__ __forceinline__ float gelu_tanh(float y) {
    const float a = 0.7978845608f * (y + 0.044715f * y * y * y);
    const float t = 1.0f - 2.0f / (1.0f + fast_exp(2.0f * a));
    return 0.5f * y * (1.0f + t);
}
__device__ __forceinline__ void unpack8(const u32x4 u, float (&f)[8]) {
    f[0] = bf_lo(u.x); f[1] = bf_hi(u.x); f[2] = bf_lo(u.y); f[3] = bf_hi(u.y); f[4] = bf_lo(u.z); f[5] = bf_hi(u.z); f[6] = bf_lo(u.w); f[7] = bf_hi(u.w);
}
__device__ __forceinline__ u32x4 pack8(const float (&f)[8]) {
    u32x4 w; w.x = cvt_pk_bf16(f[0], f[1]); w.y = cvt_pk_bf16(f[2], f[3]); w.z = cvt_pk_bf16(f[4], f[5]); w.w = cvt_pk_bf16(f[6], f[7]); return w;
}
__device__ __forceinline__ int cond_of_row(int r) { return r < NP ? 4 : ((r - NP) >> 11); }

namespace pg8 {
typedef unsigned short bf16_t;
constexpr int BM = 256, BK = 64, HALF = 128, HTB = HALF * BK * 2, STAGE_BYTES = 8 * HTB, NXCD = 8, WGM = 8;
__host__ __device__ __forceinline__ int lds_byte(int r, int c) { const int st = (r >> 4) * 2 + (c >> 5), rr = r & 15, cc = c & 31, ob = rr * 64 + cc * 2; return st * 1024 + (ob ^ (((ob >> 9) & 1) << 5)); }
__host__ __device__ __forceinline__ void stage_rc(int b, int& R, int& C) { const int st = b / 1024, sb = b % 1024, swz = sb ^ (((sb >> 9) & 1) << 5); R = (st >> 1) * 16 + swz / 64; C = (st & 1) * 32 + (swz % 64) / 2; }
__host__ __device__ __forceinline__ int perm32(int rho) { const int n = rho >> 4, i = rho & 15; return 8 * (i >> 2) + 4 * n + (i & 3); }

struct Unit { int pm, pn; };
struct Gemm { const bf16_t* A; const bf16_t* Bt; int lda, ldb, K; };

struct Sched {
    int nM, nN, nwg, G, c, mode;
    __device__ void init(int nM_, int nN_, int G_, int c_, int mode_) { nM = nM_; nN = nN_; nwg = nM * nN; G = G_; c = c_; mode = mode_; }
    __device__ bool next(int i, Unit& u) const {
        const long L = (long)i * G + c; if (L >= nwg) return false;
        if (mode == 2) { u.pm = (int)L; u.pn = (int)L / 3; return true; }
        if (mode == 3) { const int x = (int)L & 7, k = (int)L >> 3; u.pm = x + 8 * (k >> 2); u.pn = k & 3; return true; }
        int wgid = (int)L; { const int q = nwg / NXCD, r = nwg % NXCD, xcd = wgid % NXCD, off = wgid / NXCD; wgid = (xcd < r ? xcd * (q + 1) : r * (q + 1) + (xcd - r) * q) + off; }
        const int nig = WGM * nN, gid = wgid / nig, fm = gid * WGM, gsz = (nM - fm) < WGM ? (nM - fm) : WGM;
        u.pm = fm + ((wgid % nig) % gsz); u.pn = (wgid % nig) / gsz;
        if (mode == 1 && u.pn >= 4) u.pn += 2;
        return true;
    }
};

template <class T, class = void> struct is_fused { static constexpr bool value = false; };
template <class T> struct is_fused<T, decltype((void)T::FUSED)> { static constexpr bool value = true; };
template <class Epi>
__device__ __forceinline__ void gemm_phase(LAS unsigned char* lds, const int wid, const Gemm g, const Sched& S, const Epi& E) {
    const int lane = lane_id(), tid = wid * 64 + lane, wr = wid >> 2, wc = wid & 3, fr = lane & 15, fq = lane >> 4;
    const int K = g.K, nt = K / BK;
    unsigned voffA[2], voffB[2];
#pragma unroll
    for (int i = 0; i < 2; ++i) { int R, C; stage_rc(tid * 16 + i * 8192, R, C); const int Rb = (R & ~31) + perm32(R & 31);
        voffA[i] = (unsigned)(R * g.lda + C) * 2u; voffB[i] = (unsigned)(Rb * g.ldb + C) * 2u; }
    const size_t kstep = (size_t)(BK * 2);
    const size_t hA = (size_t)HALF * g.lda * 2, hB = (size_t)HALF * g.ldb * 2;
    const size_t tA = 2 * hA, tB = 2 * hB;
    const unsigned ldsw = (unsigned)wid * 1024u;
    const int aoff = lds_byte(wr * 64 + fr, fq * 8), boff = lds_byte(wc * 32 + fr, fq * 8);
#define PG8_SA(b, h) (((b) * 2 + (h)) * HTB)
#define PG8_SB(b, h) ((4 + (b) * 2 + (h)) * HTB)
#define PG8_STAGE(bufoff, gbase, voff) do { _Pragma("unroll") for (int _i = 0; _i < 2; ++_i) \
        __builtin_amdgcn_global_load_lds((const unsigned*)((const char*)(gbase) + (voff)[_i]), (LAS unsigned*)(lds + (bufoff) + ldsw + _i * 8192), 16, 0, 0); } while (0)
#define PG8_LDA(dst, b, h) do { _Pragma("unroll") for (int m = 0; m < 4; ++m) _Pragma("unroll") for (int k = 0; k < 2; ++k) dst[m][k] = *(const LAS bf16x8*)(lds + PG8_SA(b, h) + aoff + m * 2048 + k * 1024); } while (0)
#define PG8_LDB(dst, b, h) do { _Pragma("unroll") for (int n = 0; n < 2; ++n) _Pragma("unroll") for (int k = 0; k < 2; ++k) dst[n][k] = *(const LAS bf16x8*)(lds + PG8_SB(b, h) + boff + n * 2048 + k * 1024); } while (0)
#define PG8_MMA(ai, bj, At, Bt) do { __builtin_amdgcn_s_setprio(1); _Pragma("unroll") for (int m = 0; m < 4; ++m) _Pragma("unroll") for (int n = 0; n < 2; ++n) _Pragma("unroll") for (int k = 0; k < 2; ++k) \
        acc[ai][bj][m][n] = __builtin_amdgcn_mfma_f32_16x16x32_bf16(Bt[n][k], At[m][k], acc[ai][bj][m][n], 0, 0, 0); __builtin_amdgcn_s_setprio(0); } while (0)
#define PG8_WAIT_V(n) asm volatile("s_waitcnt vmcnt(" #n ")" ::: "memory")
#define PG8_WAIT_L(n) asm volatile("s_waitcnt lgkmcnt(" #n ")" ::: "memory")
#define PG8_BAR __builtin_amdgcn_s_barrier()
#define PG8_SCHED __builtin_amdgcn_sched_barrier(0)
    Unit cur, nxt; int ui = 0;
    if (!S.next(0, cur)) return;
    f32x4 acc[2][2][4][2];
#pragma unroll
    for (int a = 0; a < 2; ++a)
#pragma unroll
        for (int b = 0; b < 2; ++b)
#pragma unroll
            for (int m = 0; m < 4; ++m)
#pragma unroll
                for (int n = 0; n < 2; ++n) acc[a][b][m][n] = (f32x4){0.f, 0.f, 0.f, 0.f};
    bf16x8 At[4][2], B0[2][2], B1[2][2];
    const char* cA = (const char*)g.A + (size_t)cur.pm * tA; const char* cB = (const char*)g.Bt + (size_t)cur.pn * tB;
    PG8_STAGE(PG8_SB(0, 0), cB, voffB); PG8_STAGE(PG8_SB(0, 1), cB + hB, voffB); PG8_STAGE(PG8_SA(0, 0), cA, voffA); PG8_STAGE(PG8_SA(0, 1), cA + hA, voffA);
    if (wr == 1) PG8_BAR;
    PG8_WAIT_V(2); PG8_BAR;
    PG8_STAGE(PG8_SB(1, 0), cB + kstep, voffB); PG8_STAGE(PG8_SA(1, 0), cA + kstep, voffA); PG8_STAGE(PG8_SB(1, 1), cB + hB + kstep, voffB);
    PG8_WAIT_V(6); PG8_BAR;
    for (;;) {
        const bool has_next = S.next(ui + 1, nxt);
        const char* nA = has_next ? (const char*)g.A + (size_t)nxt.pm * tA : cA; const char* nB = has_next ? (const char*)g.Bt + (size_t)nxt.pn * tB : cB;
        for (int t = 0; t < nt; t += 2) {
            const bool last = (t == nt - 2);
            const char* a1 = cA + (size_t)(t + 1) * kstep;
            const char* a2 = last ? nA : cA + (size_t)(t + 2) * kstep; const char* b2 = last ? nB : cB + (size_t)(t + 2) * kstep;
            const char* a3 = a2 + kstep; const char* b3 = b2 + kstep;
            PG8_LDB(B0, 0, 0); PG8_LDB(B1, 0, 1); PG8_SCHED; PG8_LDA(At, 0, 0); PG8_STAGE(PG8_SA(1, 1), a1 + hA, voffA);
            PG8_WAIT_V(8); PG8_WAIT_L(0); PG8_BAR; PG8_MMA(0, 0, At, B0); PG8_MMA(0, 1, At, B1); PG8_BAR; PG8_SCHED;
            PG8_LDA(At, 0, 1); PG8_STAGE(PG8_SB(0, 0), b2, voffB); PG8_STAGE(PG8_SB(0, 1), b2 + hB, voffB); PG8_STAGE(PG8_SA(0, 0), a2, voffA);
            PG8_WAIT_V(8); PG8_WAIT_L(0); PG8_BAR; PG8_MMA(1, 0, At, B0); PG8_MMA(1, 1, At, B1); PG8_BAR; PG8_SCHED;
            PG8_LDB(B0, 1, 0); PG8_LDB(B1, 1, 1); PG8_SCHED; PG8_LDA(At, 1, 0); PG8_STAGE(PG8_SA(0, 1), a2 + hA, voffA);
            PG8_WAIT_V(8); PG8_WAIT_L(0); PG8_BAR; PG8_MMA(0, 0, At, B0); PG8_MMA(0, 1, At, B1); PG8_BAR; PG8_SCHED;
            PG8_LDA(At, 1, 1); PG8_STAGE(PG8_SB(1, 0), b3, voffB); PG8_STAGE(PG8_SB(1, 1), b3 + hB, voffB); PG8_STAGE(PG8_SA(1, 0), a3, voffA);
            PG8_WAIT_V(8); PG8_WAIT_L(0); PG8_BAR; PG8_MMA(1, 0, At, B0); PG8_MMA(1, 1, At, B1); PG8_BAR; PG8_SCHED;
        }
        if (wr == 0) PG8_BAR;
        if constexpr (is_fused<Epi>::value) E.fused(acc, cur, wr, wc, fr, fq, wid, lane); else E(acc, cur, wr, wc, fr, fq);
        if (!has_next) break;
#pragma unroll
        for (int a = 0; a < 2; ++a)
#pragma unroll
            for (int b = 0; b < 2; ++b)
#pragma unroll
                for (int m = 0; m < 4; ++m)
#pragma unroll
                    for (int n = 0; n < 2; ++n) acc[a][b][m][n] = (f32x4){0.f, 0.f, 0.f, 0.f};
        cur = nxt; cA = nA; cB = nB; ++ui;
        if (wr == 1) PG8_BAR;
    }
    PG8_WAIT_V(0);
    PG8_BAR;
#undef PG8_SA
#undef PG8_SB
#undef PG8_STAGE
#undef PG8_LDA
#undef PG8_LDB
#undef PG8_MMA
#undef PG8_WAIT_V
#undef PG8_WAIT_L
#undef PG8_BAR
#undef PG8_SCHED
}

template <int ACT  > struct EpiStore {
    bf16_t* O; int ldc;
    __device__ __forceinline__ void operator()(const f32x4 (&acc)[2][2][4][2], const Unit& u, int wr, int wc, int fr, int fq) const {
        const int row0 = u.pm * BM + wr * 64 + fr, col0 = u.pn * BM + wc * 32 + 8 * fq;
#pragma unroll
        for (int ai = 0; ai < 2; ++ai)
#pragma unroll
            for (int m = 0; m < 4; ++m) { bf16_t* rowp = O + (size_t)(row0 + ai * HALF + m * 16) * ldc + col0;
#pragma unroll
                for (int bj = 0; bj < 2; ++bj) { f32x4 v0 = acc[ai][bj][m][0], v1 = acc[ai][bj][m][1];
                    if (ACT == 1) {
#pragma unroll
                        for (int i = 0; i < 4; ++i) { const float a = fmaxf(v0[i], 0.f), b = fmaxf(v1[i], 0.f); v0[i] = a * a; v1[i] = b * b; } }
                    u32x4 w; w.x = cvt_pk_bf16(v0[0], v0[1]); w.y = cvt_pk_bf16(v0[2], v0[3]); w.z = cvt_pk_bf16(v1[0], v1[1]); w.w = cvt_pk_bf16(v1[2], v1[3]);
                    *(u32x4*)(rowp + bj * HALF) = w; } }
    }
};
struct EpiResGate {
    const float* xp; const float* xs; float* out; const float* gates;
    __device__ __forceinline__ void operator()(const f32x4 (&acc)[2][2][4][2], const Unit& u, int wr, int wc, int fr, int fq) const {
        const int rb = u.pm * BM; const float* gate = gates + cond_of_row(rb) * 6144;
        const float* base = xp ? (rb < NP ? xp : xs - (size_t)NP * D) : out;
        const int row0 = rb + wr * 64 + fr, col0 = u.pn * BM + wc * 32 + 8 * fq;
        f32x4 gv[2][2];
#pragma unroll
        for (int bj = 0; bj < 2; ++bj)
#pragma unroll
            for (int n = 0; n < 2; ++n) gv[bj][n] = *(const f32x4*)(gate + col0 + bj * HALF + 4 * n);
#pragma unroll
        for (int ai = 0; ai < 2; ++ai)
#pragma unroll
            for (int m = 0; m < 4; ++m) { const size_t ro = (size_t)(row0 + ai * HALF + m * 16) * D + col0;
#pragma unroll
                for (int bj = 0; bj < 2; ++bj)
#pragma unroll
                    for (int n = 0; n < 2; ++n) { const f32x4 b = *(const f32x4*)(base + ro + bj * HALF + 4 * n);
                        *(f32x4*)(out + ro + bj * HALF + 4 * n) = b + gv[bj][n] * acc[ai][bj][m][n]; } }
    }
};
struct EpiResGateNorm {
    static constexpr bool FUSED = true;
    const float* xp; const float* xs; float* out; const float* gates;
    const float* gam; const float* modn; int sidx; bf16_t* Hn;
    float* xbuf; unsigned* cnt; LAS unsigned char* l2; bf16_t* XB;
    __device__ __forceinline__ void fused(f32x4 (&acc)[2][2][4][2], const Unit& u, int wr, int wc, int fr, int fq, int wid, int lane) const {
        LAS float* P = (LAS float*)l2;
        LAS float* S = (LAS float*)(l2 + 4096);
        const int rb = u.pm * BM; const int cnd = cond_of_row(rb); const float* gate = gates + cnd * 6144;
        const float* base = xp ? (rb < NP ? xp : xs - (size_t)NP * D) : out;
        const int row0 = rb + wr * 64 + fr, col0 = u.pn * BM + wc * 32 + 8 * fq;
        {
            f32x4 gv[2][2];
#pragma unroll
            for (int bj = 0; bj < 2; ++bj)
#pragma unroll
                for (int n = 0; n < 2; ++n) gv[bj][n] = *(const f32x4*)(gate + col0 + bj * HALF + 4 * n);
#pragma unroll
            for (int am = 0; am < 4; ++am) {
                const int ai = am >> 1, m0 = (am & 1) * 2;
                f32x4 bb[2][2][2];
#pragma unroll
                for (int mm = 0; mm < 2; ++mm)
#pragma unroll
                    for (int bj = 0; bj < 2; ++bj)
#pragma unroll
                        for (int n = 0; n < 2; ++n) if (xp) bb[mm][bj][n] = *(const f32x4*)(base + (size_t)(row0 + ai * HALF + (m0 + mm) * 16) * D + col0 + bj * HALF + 4 * n);
                if (!xp) {
                    u32x4 rb4[2][2];
#pragma unroll
                    for (int mm = 0; mm < 2; ++mm)
#pragma unroll
                        for (int bj = 0; bj < 2; ++bj) rb4[mm][bj] = *(const u32x4*)(XB + (size_t)(row0 + ai * HALF + (m0 + mm) * 16) * D + col0 + bj * HALF);
#pragma unroll
                    for (int mm = 0; mm < 2; ++mm)
#pragma unroll
                        for (int bj = 0; bj < 2; ++bj) { float f[8]; unpack8(rb4[mm][bj], f);
                            bb[mm][bj][0] = (f32x4){f[0], f[1], f[2], f[3]}; bb[mm][bj][1] = (f32x4){f[4], f[5], f[6], f[7]}; }
                }
#pragma unroll
                for (int mm = 0; mm < 2; ++mm) { const int m = m0 + mm; const size_t ro = (size_t)(row0 + ai * HALF + m * 16) * D + col0; float s = 0.f;
#pragma unroll
                    for (int bj = 0; bj < 2; ++bj)
#pragma unroll
                        for (int n = 0; n < 2; ++n) {
                            const f32x4 v = bb[mm][bj][n] + gv[bj][n] * acc[ai][bj][m][n]; acc[ai][bj][m][n] = v;
                            s += (v[0] * v[0] + v[1] * v[1]) + (v[2] * v[2] + v[3] * v[3]); }
                    s += __shfl_xor(s, 16); s += __shfl_xor(s, 32);
                    if (fq == 0) P[(ai * HALF + wr * 64 + m * 16 + fr) * 4 + wc] = s; }
            }
        }
        asm volatile("s_waitcnt lgkmcnt(0)" ::: "memory"); __builtin_amdgcn_s_barrier(); asm volatile("" ::: "memory");
        const int prow = wid * 32 + (lane & 31);
        if (lane < 32) {
            const float tot = (P[prow * 4 + 0] + P[prow * 4 + 1]) + (P[prow * 4 + 2] + P[prow * 4 + 3]);
            __hip_atomic_store(xbuf + ((size_t)(rb + prow) * 4 + u.pn), tot, __ATOMIC_RELAXED, __HIP_MEMORY_SCOPE_AGENT);
        }
        asm volatile("s_waitcnt vmcnt(0)" ::: "memory");
        if (lane == 0) __hip_atomic_fetch_add(cnt + 64 * u.pm, 1u, __ATOMIC_RELAXED, __HIP_MEMORY_SCOPE_AGENT);
        if (Hn) {
#pragma unroll
            for (int ai = 0; ai < 2; ++ai)
#pragma unroll
                for (int m = 0; m < 4; ++m) { bf16_t* op = XB + (size_t)(row0 + ai * HALF + m * 16) * D + col0;
#pragma unroll
                    for (int bj = 0; bj < 2; ++bj) { const f32x4 v0 = acc[ai][bj][m][0], v1 = acc[ai][bj][m][1];
                        u32x4 w; w.x = cvt_pk_bf16(v0[0], v0[1]); w.y = cvt_pk_bf16(v0[2], v0[3]); w.z = cvt_pk_bf16(v1[0], v1[1]); w.w = cvt_pk_bf16(v1[2], v1[3]);
                        *(u32x4*)(op + bj * HALF) = w; } }
        }
        if (wid == 0) {
            unsigned sp = 0;
            for (;;) {
                if ((unsigned)__builtin_amdgcn_readfirstlane(__hip_atomic_load(cnt + 64 * u.pm, __ATOMIC_RELAXED, __HIP_MEMORY_SCOPE_AGENT)) >= 32u) break;
                if (++sp > (1u << 20)) break;
                __builtin_amdgcn_s_sleep(2);
            }
            __builtin_amdgcn_fence(__ATOMIC_ACQUIRE, "agent");
        }
        asm volatile("s_waitcnt vmcnt(0) lgkmcnt(0)" ::: "memory"); __builtin_amdgcn_s_barrier(); asm volatile("" ::: "memory");
        if (lane < 32) {
            const float* slot = xbuf + (size_t)(rb + prow) * 4; float tot = 0.f;
#pragma unroll
            for (int t = 0; t < 4; ++t) tot += __hip_atomic_load(slot + t, __ATOMIC_RELAXED, __HIP_MEMORY_SCOPE_AGENT);
            S[prow] = 1.0f / sqrtf(tot * (1.0f / D) + EPS);
        }
        asm volatile("s_waitcnt vmcnt(0) lgkmcnt(0)" ::: "memory"); __builtin_amdgcn_s_barrier(); asm volatile("" ::: "memory");
        const float* sh = modn + cnd * 6144 + sidx * 1024; const float* sc = sh + 1024;
#pragma unroll
        for (int bj = 0; bj < 2; ++bj) {
            const int c = col0 + bj * HALF;
            f32x4 g0 = *(const f32x4*)(gam + c), g1 = *(const f32x4*)(gam + c + 4), h0 = (f32x4){0.f, 0.f, 0.f, 0.f}, h1 = h0;
            if (Hn) { g0 = g0 * (*(const f32x4*)(sc + c) + 1.0f); g1 = g1 * (*(const f32x4*)(sc + c + 4) + 1.0f); h0 = *(const f32x4*)(sh + c); h1 = *(const f32x4*)(sh + c + 4); }
#pragma unroll
            for (int ai = 0; ai < 2; ++ai)
#pragma unroll
                for (int m = 0; m < 4; ++m) { const int rl = ai * HALF + wr * 64 + m * 16 + fr; const float rstd = S[rl];
                    const f32x4 o0 = acc[ai][bj][m][0] * rstd * g0 + h0, o1 = acc[ai][bj][m][1] * rstd * g1 + h1;
                    if (Hn) { u32x4 w; w.x = cvt_pk_bf16(o0[0], o0[1]); w.y = cvt_pk_bf16(o0[2], o0[3]); w.z = cvt_pk_bf16(o1[0], o1[1]); w.w = cvt_pk_bf16(o1[2], o1[3]);
                        *(u32x4*)(Hn + (size_t)(rb + rl) * D + c) = w; }
                    else { float* o = out + (size_t)(rb + rl) * D + c; *(f32x4*)o = o0; *(f32x4*)(o + 4) = o1; } }
        }
    }
};
struct EpiProj1 {
    bf16_t* QKV; bf16_t* ABUF; float* outK;
    __device__ __forceinline__ void operator()(const f32x4 (&acc)[2][2][4][2], const Unit& u, int wr, int wc, int fr, int fq) const {
        const int row0 = u.pm * BM + wr * 64 + fr, col0 = u.pn * BM + wc * 32 + 8 * fq;
#pragma unroll
        for (int ai = 0; ai < 2; ++ai)
#pragma unroll
            for (int m = 0; m < 4; ++m) { const int r = row0 + ai * HALF + m * 16;
#pragma unroll
                for (int bj = 0; bj < 2; ++bj) { const int c = col0 + bj * HALF; const f32x4 v0 = acc[ai][bj][m][0], v1 = acc[ai][bj][m][1];
                    u32x4 w; w.x = cvt_pk_bf16(v0[0], v0[1]); w.y = cvt_pk_bf16(v0[2], v0[3]); w.z = cvt_pk_bf16(v1[0], v1[1]); w.w = cvt_pk_bf16(v1[2], v1[3]);
                    if (u.pn < 4) {
                        *(u32x4*)(QKV + (size_t)r * QP + c) = w;
                        if (u.pn >= 2 && r < NP) { const int b = r >> 8, t = r & 255, hh = (c - 512) >> 6, d = (c - 512) & 63;
                            float* o = outK + ((size_t)((b * 8 + hh) * 256 + t)) * 64 + d; *(f32x4*)o = v0; *(f32x4*)(o + 4) = v1; }
                    } else { const int cu = c - 1536, gg = cu >> 4, gi0 = cu & 15, chunk = r >> 4, j = r & 15;
                        *(u32x4*)(ABUF + ((size_t)(gg * 768 + chunk)) * 512 + j * 16 + gi0) = w; }
                } }
    }
};
struct EpiVT {
    bf16_t* VTP; bf16_t* VTS; float* outV;
    __device__ __forceinline__ void operator()(const f32x4 (&acc)[2][2][4][2], const Unit& u, int wr, int wc, int fr, int fq) const {
        const int row0 = u.pm * BM + wr * 64 + fr, col0 = u.pn * BM + wc * 32 + 8 * fq;
#pragma unroll
        for (int ai = 0; ai < 2; ++ai)
#pragma unroll
            for (int m = 0; m < 4; ++m) { const int c = row0 + ai * HALF + m * 16, hh = c >> 6, d = c & 63;
#pragma unroll
                for (int bj = 0; bj < 2; ++bj) { const int r0 = col0 + bj * HALF; const f32x4 v0 = acc[ai][bj][m][0], v1 = acc[ai][bj][m][1];
                    u32x4 w; w.x = cvt_pk_bf16(v0[0], v0[1]); w.y = cvt_pk_bf16(v0[2], v0[3]); w.z = cvt_pk_bf16(v1[0], v1[1]); w.w = cvt_pk_bf16(v1[2], v1[3]);
                    if (r0 < NP) { const int b = r0 >> 8, t0 = r0 & 255;
                        *(u32x4*)(VTP + ((size_t)((b * 8 + hh) * 64 + d)) * VPP + t0) = w;
                        float* o = outV + ((size_t)((b * 8 + hh) * 256 + t0)) * 64 + d;
#pragma unroll
                        for (int i = 0; i < 4; ++i) { o[i * 64] = v0[i]; o[(i + 4) * 64] = v1[i]; }
                    } else { const int rs = r0 - NP, b = rs >> 11, t0 = rs & 2047;
                        *(u32x4*)(VTS + ((size_t)((b * 8 + hh) * 64 + d)) * VSP + t0) = w; }
                } }
    }
};
struct EpiF {
    float* F;
    __device__ __forceinline__ void operator()(const f32x4 (&acc)[2][2][4][2], const Unit& u, int wr, int wc, int fr, int fq) const {
        const int row0 = u.pm * BM + wr * 64 + fr, col0 = wc * 32 + 8 * fq;
#pragma unroll
        for (int ai = 0; ai < 2; ++ai)
#pragma unroll
            for (int m = 0; m < 4; ++m) { float* rowp = F + (size_t)(row0 + ai * HALF + m * 16) * 256 + col0;
#pragma unroll
                for (int bj = 0; bj < 2; ++bj) { *(f32x4*)(rowp + bj * HALF) = acc[ai][bj][m][0]; *(f32x4*)(rowp + bj * HALF + 4) = acc[ai][bj][m][1]; } }
    }
};
struct EpiY {
    bf16_t* Y;
    __device__ __forceinline__ void operator()(const f32x4 (&acc)[2][2][4][2], const Unit& u, int wr, int wc, int fr, int fq) const {
        const int gg = u.pn, row0 = u.pm * BM + wr * 64 + fr - gg * 768, col0 = wc * 32 + 8 * fq;
#pragma unroll
        for (int ai = 0; ai < 2; ++ai)
#pragma unroll
            for (int m = 0; m < 4; ++m) { const int chunk = row0 + ai * HALF + m * 16;
#pragma unroll
                for (int bj = 0; bj < 2; ++bj) { const int n = col0 + bj * HALF, t = n >> 4, go0 = n & 15; const f32x4 v0 = acc[ai][bj][m][0], v1 = acc[ai][bj][m][1];
                    u32x4 w; w.x = cvt_pk_bf16(gelu_tanh(v0[0]), gelu_tanh(v0[1])); w.y = cvt_pk_bf16(gelu_tanh(v0[2]), gelu_tanh(v0[3]));
                    w.z = cvt_pk_bf16(gelu_tanh(v1[0]), gelu_tanh(v1[1])); w.w = cvt_pk_bf16(gelu_tanh(v1[2]), gelu_tanh(v1[3]));
                    *(u32x4*)(Y + ((size_t)(chunk * 16 + t)) * 512 + gg * 16 + go0) = w; } }
    }
};
struct EpiGLU {
    const bf16_t* Y; bf16_t* Z; const float* bias;
    __device__ __forceinline__ void operator()(const f32x4 (&acc)[2][2][4][2], const Unit& u, int wr, int wc, int fr, int fq) const {
        const int row0 = u.pm * BM + wr * 64 + fr, col0 = u.pn * BM + wc * 32 + 8 * fq;
#pragma unroll
        for (int ai = 0; ai < 2; ++ai)
#pragma unroll
            for (int m = 0; m < 4; ++m) { const int r = row0 + ai * HALF + m * 16;
#pragma unroll
                for (int bj = 0; bj < 2; ++bj) { const int c = col0 + bj * HALF; const f32x4 v0 = acc[ai][bj][m][0], v1 = acc[ai][bj][m][1];
                    const u32x4 yu = *(const u32x4*)(Y + (size_t)r * 512 + c); float y[8]; unpack8(yu, y);
                    const f32x4 b0 = *(const f32x4*)(bias + c), b1 = *(const f32x4*)(bias + c + 4);
                    float o[8];
#pragma unroll
                    for (int i = 0; i < 4; ++i) { o[i] = y[i] * sigmoidf_(v0[i] + b0[i]); o[i + 4] = y[i + 4] * sigmoidf_(v1[i] + b1[i]); }
                    *(u32x4*)(Z + (size_t)r * D + 512 + c) = pack8(o); } }
    }
};
}

__device__ __forceinline__ void tr_item(const float* W, int N, bf16* WT, int ldt, LAS float* scr, int item, int lane) {
    const int nblk = N / 32, kb = item / nblk, nb = item % nblk, k0 = 64 * kb, n0 = 32 * nb;
    float tv[32];
#pragma unroll
    for (int i = 0; i < 32; ++i) tv[i] = W[(size_t)(k0 + 2 * i + (lane >> 5)) * N + n0 + (lane & 31)];
#pragma unroll
    for (int i = 0; i < 32; ++i) scr[(2 * i + (lane >> 5)) * 33 + (lane & 31)] = tv[i];
    asm volatile("s_waitcnt lgkmcnt(0)" ::: "memory");
    const int c = lane & 7;
#pragma unroll
    for (int j = 0; j < 4; ++j) { const int n = (lane >> 3) + 8 * j; const LAS float* s = scr + (8 * c) * 33 + n;
        u32x4 o; o.x = cvt_pk_bf16(s[0 * 33], s[1 * 33]); o.y = cvt_pk_bf16(s[2 * 33], s[3 * 33]); o.z = cvt_pk_bf16(s[4 * 33], s[5 * 33]); o.w = cvt_pk_bf16(s[6 * 33], s[7 * 33]);
        *(u32x4*)(WT + (size_t)(n0 + n) * ldt + k0 + 8 * c) = o; }
    asm volatile("s_waitcnt lgkmcnt(0)" ::: "memory");
}

__device__ __forceinline__ f32x2 cmul(f32x2 a, f32x2 b) { return (f32x2){a.x * b.x - a.y * b.y, a.x * b.y + a.y * b.x}; }
__device__ __forceinline__ f32x2 lam_pow(float lre, float lim, float st, int d) {
    const float mag = fast_exp(lre * st * (float)d);
    const double rev = (double)lim * (double)st * (double)d * 0.15915494309189535;
    const float fr = (float)(rev - __builtin_rint(rev));
    return (f32x2){mag * __builtin_amdgcn_cosf(fr), mag * __builtin_amdgcn_sinf(fr)};
}

__device__ __forceinline__ void rms_mod_rows(const float* xp, const float* xs_m, bf16* H, const float* gam, const float* modl, int sidx, int gw, int NGW, int lane) {
    for (int r = gw; r < NTOK; r += 2 * NGW) {
        const int r1 = r + NGW; const bool has1 = r1 < NTOK; const int r1c = has1 ? r1 : r;
        const float* xr0 = (r < NP ? xp : xs_m) + (size_t)r * D; const float* xr1 = (r1c < NP ? xp : xs_m) + (size_t)r1c * D;
        f32x4 v0[4], v1[4]; float s0 = 0.f, s1 = 0.f;
#pragma unroll
        for (int j = 0; j < 4; ++j) { v0[j] = *((const f32x4*)xr0 + lane + 64 * j); v1[j] = *((const f32x4*)xr1 + lane + 64 * j); }
#pragma unroll
        for (int j = 0; j < 4; ++j) { s0 += (v0[j].x * v0[j].x + v0[j].y * v0[j].y) + (v0[j].z * v0[j].z + v0[j].w * v0[j].w);
                                      s1 += (v1[j].x * v1[j].x + v1[j].y * v1[j].y) + (v1[j].z * v1[j].z + v1[j].w * v1[j].w); }
        const float rstd0 = 1.0f / sqrtf(wave_sum(s0) * (1.f / D) + EPS), rstd1 = 1.0f / sqrtf(wave_sum(s1) * (1.f / D) + EPS);
        const float* sh0 = modl + cond_of_row(r) * 6144 + sidx * 1024; const float* sh1 = modl + cond_of_row(r1c) * 6144 + sidx * 1024;
#pragma unroll
        for (int j = 0; j < 4; ++j) { const int c = 4 * (lane + 64 * j);
            const f32x4 g4 = *(const f32x4*)(gam + c);
            { const f32x4 s4 = *(const f32x4*)(sh0 + 1024 + c), h4 = *(const f32x4*)(sh0 + c); const f32x4 o = (v0[j] * rstd0) * g4 * (s4 + 1.0f) + h4;
              u32x2 w; w.x = cvt_pk_bf16(o.x, o.y); w.y = cvt_pk_bf16(o.z, o.w); *(u32x2*)(H + (size_t)r * D + c) = w; }
            if (has1) { const f32x4 s4 = *(const f32x4*)(sh1 + 1024 + c), h4 = *(const f32x4*)(sh1 + c); const f32x4 o = (v1[j] * rstd1) * g4 * (s4 + 1.0f) + h4;
              u32x2 w; w.x = cvt_pk_bf16(o.x, o.y); w.y = cvt_pk_bf16(o.z, o.w); *(u32x2*)(H + (size_t)r1 * D + c) = w; }
        }
    }
}

__device__ __forceinline__ void wait_vm(int n) {
    switch (n) {
        case 0: asm volatile("s_waitcnt vmcnt(0)" ::: "memory"); break;   case 1: asm volatile("s_waitcnt vmcnt(1)" ::: "memory"); break;
        case 2: asm volatile("s_waitcnt vmcnt(2)" ::: "memory"); break;   case 3: asm volatile("s_waitcnt vmcnt(3)" ::: "memory"); break;
        case 4: asm volatile("s_waitcnt vmcnt(4)" ::: "memory"); break;   case 5: asm volatile("s_waitcnt vmcnt(5)" ::: "memory"); break;
        case 6: asm volatile("s_waitcnt vmcnt(6)" ::: "memory"); break;   case 7: asm volatile("s_waitcnt vmcnt(7)" ::: "memory"); break;
        case 8: asm volatile("s_waitcnt vmcnt(8)" ::: "memory"); break;   case 9: asm volatile("s_waitcnt vmcnt(9)" ::: "memory"); break;
        case 10: asm volatile("s_waitcnt vmcnt(10)" ::: "memory"); break; case 11: asm volatile("s_waitcnt vmcnt(11)" ::: "memory"); break;
        case 12: asm volatile("s_waitcnt vmcnt(12)" ::: "memory"); break; case 13: asm volatile("s_waitcnt vmcnt(13)" ::: "memory"); break;
        case 14: asm volatile("s_waitcnt vmcnt(14)" ::: "memory"); break; default: asm volatile("s_waitcnt vmcnt(15)" ::: "memory"); break;
    }
}
__device__ __forceinline__ void dma16(const bf16* g, LAS unsigned char* l) { __builtin_amdgcn_global_load_lds((const unsigned*)g, (LAS unsigned*)l, 16, 0, 0); }
template <bool BIAS, int kpitchA, int rsA, int vpitchA>
__device__ __forceinline__ void attn_seg(const bf16x8 qf0, const bf16x8 qf1, const bf16* kA, const bf16* vtA, LAS unsigned char* wl,
                                         const LAS float* rpbh, int r, int r0, int s0, int cb, int lane, float& mout, float& sumout, f32x4 (&o)[4]) {
    const int l16 = lane & 15, g4 = lane >> 4;
    const LAS unsigned char* rl = wl + lane * 16;
    f32x4 s[16];
    constexpr int RK = 8;
    const bf16* kbase = kA + (size_t)((l16 >> 2) * 8 + (l16 & 3)) * kpitchA + g4 * 8;
    const bf16* kr = kbase;
#pragma unroll
    for (int t = 0; t < RK - 1; ++t) { dma16(kr, wl + t * 2048); dma16(kr + 32, wl + t * 2048 + 1024);
        kr += (size_t)((t & 1) ? (rsA - 4) : 4) * kpitchA; asm volatile("" : "+v"(kr)); }
#pragma unroll
    for (int t = 0; t < 16; ++t) {
        if (t + RK - 1 < 16) { const int tn = t + RK - 1;
            dma16(kr, wl + (tn % RK) * 2048); dma16(kr + 32, wl + (tn % RK) * 2048 + 1024);
            kr += (size_t)((tn & 1) ? (rsA - 4) : 4) * kpitchA; asm volatile("" : "+v"(kr)); }
        wait_vm(2 * ((15 - t) < (RK - 1) ? (15 - t) : (RK - 1)));
        const bf16x8 a0 = *(const LAS bf16x8*)(rl + (t % RK) * 2048), a1 = *(const LAS bf16x8*)(rl + (t % RK) * 2048 + 1024);
        f32x4 z = (f32x4){0.f, 0.f, 0.f, 0.f};
        z = __builtin_amdgcn_mfma_f32_16x16x32_bf16(a0, qf0, z, 0, 0, 0);
        s[t] = __builtin_amdgcn_mfma_f32_16x16x32_bf16(a1, qf1, z, 0, 0, 0);
        __builtin_amdgcn_sched_barrier(0);
    }
    constexpr int RV = 16;
    const bf16* vbase = vtA + (size_t)l16 * vpitchA + g4 * 8;
    asm volatile("s_waitcnt lgkmcnt(0)" ::: "memory");
    const bf16* vr = vbase;
#pragma unroll
    for (int q = 0; q < RV - 1; ++q) { dma16(vr, wl + q * 1024);
        vr += ((q & 3) == 3) ? (ptrdiff_t)rsA - (ptrdiff_t)48 * vpitchA : (ptrdiff_t)16 * vpitchA; asm volatile("" : "+v"(vr)); }
    __builtin_amdgcn_sched_barrier(0);
    float mx = -3.0e38f;
    constexpr float SC = 0.125f * 1.44269504089f, L2E = 1.44269504089f;
    if (BIAS) {
        int cidx[8];
        const int qc = cb * 16 + l16; int c0 = qc - 8; c0 = c0 < 0 ? 0 : (c0 > 48 ? 48 : c0);
#pragma unroll
        for (int e = 0; e < 8; ++e) { const int x = g4 * 8 + e, kc = s0 + x; int co = kc - qc; co = co < -15 ? -15 : (co > 15 ? 15 : co);
            cidx[e] = (kc >= c0 && kc < c0 + 16) ? (co + 15) : -1; }
#pragma unroll
        for (int t = 0; t < 16; ++t) { const int y = t >> 1; const LAS float* rp = rpbh + (r0 + y - r + 7) * 31;
#pragma unroll
            for (int i = 0; i < 4; ++i) { const int ci = cidx[(t & 1) * 4 + i];
                const float bsv = rp[ci >= 0 ? ci : 0];
                const float v = ci >= 0 ? s[t][i] * SC + bsv * L2E : -1.0e30f; s[t][i] = v; mx = fmaxf(mx, v); } }
    } else {
#pragma unroll
        for (int t = 0; t < 16; ++t)
#pragma unroll
            for (int i = 0; i < 4; ++i) { const float v = s[t][i] * SC; s[t][i] = v; mx = fmaxf(mx, v); }
    }
    mx = fmaxf(mx, __shfl_xor(mx, 16)); mx = fmaxf(mx, __shfl_xor(mx, 32));
    float sum = 0.f;
#pragma unroll
    for (int dt = 0; dt < 4; ++dt) o[dt] = (f32x4){0.f, 0.f, 0.f, 0.f};
#pragma unroll
    for (int j = 0; j < 8; ++j) {
        float p[8];
#pragma unroll
        for (int i = 0; i < 4; ++i) { p[i] = __builtin_amdgcn_exp2f(s[2 * j][i] - mx); p[4 + i] = __builtin_amdgcn_exp2f(s[2 * j + 1][i] - mx); }
#pragma unroll
        for (int i = 0; i < 8; ++i) sum += p[i];
        const bf16x8 pb = __builtin_bit_cast(bf16x8, pack8(p));
#pragma unroll
        for (int dt = 0; dt < 4; ++dt) {
            const int q = j * 4 + dt, qn = q + RV - 1;
            if (qn < 32) { dma16(vr, wl + (qn % RV) * 1024);
                vr += ((qn & 3) == 3) ? (ptrdiff_t)rsA - (ptrdiff_t)48 * vpitchA : (ptrdiff_t)16 * vpitchA; asm volatile("" : "+v"(vr)); }
            wait_vm((31 - q) < (RV - 1) ? (31 - q) : (RV - 1));
            const bf16x8 vq = *(const LAS bf16x8*)(rl + (q % RV) * 1024);
            o[dt] = __builtin_amdgcn_mfma_f32_16x16x32_bf16(vq, pb, o[dt], 0, 0, 0);
            __builtin_amdgcn_sched_barrier(0);
        }
    }
    asm volatile("s_waitcnt lgkmcnt(0)" ::: "memory");
    sum += __shfl_xor(sum, 16); sum += __shfl_xor(sum, 32);
    mout = mx; sumout = sum;
}
template <bool NA>
__device__ __forceinline__ void attn_unit(const bf16* qrow, const bf16* kA, const bf16* vtA,
                                          const bf16* kB, const bf16* vtB, const LAS float* rpbh, int r, int r0, int s0, int cb, bf16* orow, int lane, LAS unsigned char* wl) {
    const int g4 = lane >> 4;
    const bf16x8 qf0 = *(const bf16x8*)(qrow + g4 * 8), qf1 = *(const bf16x8*)(qrow + 32 + g4 * 8);
    f32x4 o[4]; float m, sum;
    if (NA) attn_seg<true, QP, 64, VSP>(qf0, qf1, kA, vtA, wl, rpbh, r, r0, s0, cb, lane, m, sum, o);
    else attn_seg<false, QP, 32, VPP>(qf0, qf1, kA, vtA, wl, rpbh, r, r0, s0, cb, lane, m, sum, o);
    if (NA) {
        f32x4 o2[4]; float m2, sum2;
        attn_seg<false, 64, 32, VPP>(qf0, qf1, kB, vtB, wl, (const LAS float*)nullptr, 0, 0, 0, 0, lane, m2, sum2, o2);
        const float mm = fmaxf(m, m2), wa = __builtin_amdgcn_exp2f(m - mm), wb = __builtin_amdgcn_exp2f(m2 - mm);
        sum = sum * wa + sum2 * wb;
#pragma unroll
        for (int dt = 0; dt < 4; ++dt) o[dt] = o[dt] * wa + o2[dt] * wb;
    }
    const float inv = 1.0f / sum;
#pragma unroll
    for (int dt = 0; dt < 4; ++dt) { u32x2 w; w.x = cvt_pk_bf16(o[dt][0] * inv, o[dt][1] * inv); w.y = cvt_pk_bf16(o[dt][2] * inv, o[dt][3] * inv);
        *(u32x2*)(orow + dt * 16 + g4 * 4) = w; }
}


__device__ __forceinline__ int kimg_f(int kidx) { return ((kidx >> 3) & 3) | (((kidx >> 1) & 1) << 2); }
__device__ __forceinline__ int kimg_off(int kidx, int c) { return kidx * 128 + ((c ^ kimg_f(kidx)) << 4); }
__device__ __forceinline__ void stage_k(LAS unsigned char* img, const bf16* g0, int pitch, int nkeys, int wave, int lane) {
    const int kin = lane >> 3, p = lane & 7;
    for (int pc = wave; pc < (nkeys >> 3); pc += NWAVES) { const int key = pc * 8 + kin, c = p ^ kimg_f(key);
        dma16(g0 + (size_t)key * pitch + c * 8, img + pc * 1024); }
}
__device__ __forceinline__ void stage_v(LAS unsigned char* img, const bf16* g0, int gpitch, int ntok, int VB, int wave, int lane) {
    const int total = 64 * VB;
    for (int pc = wave; pc * 1024 < total; pc += NWAVES) { const int o = pc * 1024 + lane * 16; int d = o / VB, w = o - d * VB;
        if (d > 63) { d = 63; w = 0; } if (w >= ntok * 2) w = 0;
        dma16(g0 + (size_t)d * gpitch + (w >> 1), img + pc * 1024); }
}
template <bool BIAS, int RS>
__device__ __forceinline__ float qk_lds(const bf16x8 qf0, const bf16x8 qf1, const LAS unsigned char* kimg, int kwin, f32x4 (&s)[16],
                                        const LAS float* rpbh, int r, int r0, int s0, int cb, int lane) {
    const int l16 = lane & 15, g4 = lane >> 4;
    const int xl = (l16 >> 2) * 8 + (l16 & 3);
#pragma unroll
    for (int t = 0; t < 16; ++t) {
        const int kidx = kwin + (t >> 1) * RS + (t & 1) * 4 + xl;
        const bf16x8 a0 = *(const LAS bf16x8*)(kimg + kimg_off(kidx, g4)), a1 = *(const LAS bf16x8*)(kimg + kimg_off(kidx, 4 + g4));
        f32x4 z = (f32x4){0.f, 0.f, 0.f, 0.f};
        z = __builtin_amdgcn_mfma_f32_16x16x32_bf16(a0, qf0, z, 0, 0, 0);
        s[t] = __builtin_amdgcn_mfma_f32_16x16x32_bf16(a1, qf1, z, 0, 0, 0);
    }
    float mx = -3.0e38f;
    constexpr float SC = 0.125f * 1.44269504089f, L2E = 1.44269504089f;
    if (BIAS) {
        int cidx[8];
        const int qc = cb * 16 + l16; int c0 = qc - 8; c0 = c0 < 0 ? 0 : (c0 > 48 ? 48 : c0);
#pragma unroll
        for (int e = 0; e < 8; ++e) { const int x = g4 * 8 + e, kc = s0 + x; int co = kc - qc; co = co < -15 ? -15 : (co > 15 ? 15 : co);
            cidx[e] = (kc >= c0 && kc < c0 + 16) ? (co + 15) : -1; }
#pragma unroll
        for (int t = 0; t < 16; ++t) { const int y = t >> 1; const LAS float* rp = rpbh + (r0 + y - r + 7) * 31;
#pragma unroll
            for (int i = 0; i < 4; ++i) { const int ci = cidx[(t & 1) * 4 + i];
                const float bsv = rp[ci >= 0 ? ci : 0];
                const float v = ci >= 0 ? s[t][i] * SC + bsv * L2E : -1.0e30f; s[t][i] = v; mx = fmaxf(mx, v); } }
    } else {
#pragma unroll
        for (int t = 0; t < 16; ++t)
#pragma unroll
            for (int i = 0; i < 4; ++i) { const float v = s[t][i] * SC; s[t][i] = v; mx = fmaxf(mx, v); }
    }
    mx = fmaxf(mx, __shfl_xor(mx, 16)); mx = fmaxf(mx, __shfl_xor(mx, 32));
    return mx;
}
template <int RS, int VB>
__device__ __forceinline__ float pv_lds(const LAS unsigned char* vimg, int kwin, const f32x4 (&s)[16], float mx, f32x4 (&o)[4], int lane) {
    const int l16 = lane & 15, g4 = lane >> 4;
    const LAS unsigned char* vb = vimg + l16 * VB + (kwin + g4 * 8) * 2;
    float sum = 0.f;
#pragma unroll
    for (int dt = 0; dt < 4; ++dt) o[dt] = (f32x4){0.f, 0.f, 0.f, 0.f};
#pragma unroll
    for (int j = 0; j < 8; ++j) {
        float p[8];
#pragma unroll
        for (int i = 0; i < 4; ++i) { p[i] = __builtin_amdgcn_exp2f(s[2 * j][i] - mx); p[4 + i] = __builtin_amdgcn_exp2f(s[2 * j + 1][i] - mx); }
#pragma unroll
        for (int i = 0; i < 8; ++i) sum += p[i];
        const bf16x8 pb = __builtin_bit_cast(bf16x8, pack8(p));
#pragma unroll
        for (int dt = 0; dt < 4; ++dt) {
            const bf16x8 vq = *(const LAS bf16x8*)(vb + dt * 16 * VB + j * RS * 2);
            o[dt] = __builtin_amdgcn_mfma_f32_16x16x32_bf16(vq, pb, o[dt], 0, 0, 0);
        }
    }
    sum += __shfl_xor(sum, 16); sum += __shfl_xor(sum, 32);
    return sum;
}
__device__ __forceinline__ void attn_store(bf16* orow, const f32x4 (&o)[4], float sum, int lane) {
    const int g4 = lane >> 4; const float inv = 1.0f / sum;
#pragma unroll
    for (int dt = 0; dt < 4; ++dt) { u32x2 w; w.x = cvt_pk_bf16(o[dt][0] * inv, o[dt][1] * inv); w.y = cvt_pk_bf16(o[dt][2] * inv, o[dt][3] * inv);
        *(u32x2*)(orow + dt * 16 + g4 * 4) = w; }
}
#define LDS_SYNC_ALL() do { asm volatile("s_waitcnt vmcnt(0) lgkmcnt(0)" ::: "memory"); __syncthreads(); } while (0)
__device__ __forceinline__ void ctx_block_unit(int id, const bf16* QKV, const bf16* VTP, bf16* Z, LAS unsigned char* lds, int wave, int lane) {
    const int bh = id >> 1, b = bh >> 3, hh = bh & 7, qt = (id & 1) * 8 + wave, l16 = lane & 15, g4 = lane >> 4;
    const int tq = b * 256 + qt * 16 + l16;
    const bf16* qrow = QKV + (size_t)tq * QP + hh * 64;
    const bf16x8 qf0 = *(const bf16x8*)(qrow + g4 * 8), qf1 = *(const bf16x8*)(qrow + 32 + g4 * 8);
    stage_k(lds, QKV + (size_t)(b * 256) * QP + 512 + hh * 64, QP, 256, wave, lane);
    stage_v(lds + 32768, VTP + (size_t)(bh * 64) * VPP, VPP, 256, 528, wave, lane);
    LDS_SYNC_ALL();
    f32x4 s[16], o[4];
    const float mx = qk_lds<false, 32>(qf0, qf1, lds, 0, s, (const LAS float*)nullptr, 0, 0, 0, 0, lane);
    const float sum = pv_lds<32, 528>(lds + 32768, 0, s, mx, o, lane);
    attn_store(Z + (size_t)tq * D + hh * 64, o, sum, lane);
    LDS_SYNC_ALL();
}
__device__ __forceinline__ void na_block_unit(int id, const bf16* QKV, const bf16* VTS, const bf16* KC, const bf16* VTC, const LAS float* rpb_l, bf16* Z, LAS unsigned char* lds, int wave, int lane) {
    const int bh = id >> 4, rp = id & 15, b = bh >> 3, hh = bh & 7, r = 2 * rp + (wave >> 2), cb = wave & 3, l16 = lane & 15, g4 = lane >> 4;
    int r0 = r - 4; r0 = r0 < 0 ? 0 : (r0 > 24 ? 24 : r0);
    int r0a = 2 * rp - 4; r0a = r0a < 0 ? 0 : (r0a > 24 ? 24 : r0a);
    int s0 = cb * 16 - 8; s0 = s0 < 0 ? 0 : (s0 > 32 ? 32 : s0);
    const int nrows = (32 - r0a) < 9 ? (32 - r0a) : 9;
    const int tb = NP + b * 2048, tq = tb + r * 64 + cb * 16 + l16;
    const bf16* qrow = QKV + (size_t)tq * QP + hh * 64;
    const bf16x8 qf0 = *(const bf16x8*)(qrow + g4 * 8), qf1 = *(const bf16x8*)(qrow + 32 + g4 * 8);
    const int kwin = (r0 - r0a) * 64 + s0;
    stage_k(lds, QKV + (size_t)(tb + r0a * 64) * QP + 512 + hh * 64, QP, nrows * 64, wave, lane);
    LDS_SYNC_ALL();
    f32x4 s[16], o[4];
    const float m1 = qk_lds<true, 64>(qf0, qf1, lds, kwin, s, rpb_l + hh * 465, r, r0, s0, cb, lane);
    LDS_SYNC_ALL();
    stage_v(lds, VTS + (size_t)(bh * 64) * VSP + r0a * 64, VSP, nrows * 64, 1168, wave, lane);
    LDS_SYNC_ALL();
    float sum = pv_lds<64, 1168>(lds, kwin, s, m1, o, lane);
    LDS_SYNC_ALL();
    stage_k(lds, KC + (size_t)bh * 256 * 64, 64, 256, wave, lane);
    stage_v(lds + 32768, VTC + (size_t)bh * 64 * VPP, VPP, 256, 528, wave, lane);
    LDS_SYNC_ALL();
    f32x4 o2[4];
    const float m2 = qk_lds<false, 32>(qf0, qf1, lds, 0, s, (const LAS float*)nullptr, 0, 0, 0, 0, lane);
    const float sum2 = pv_lds<32, 528>(lds + 32768, 0, s, m2, o2, lane);
    const float mm = fmaxf(m1, m2), wa = __builtin_amdgcn_exp2f(m1 - mm), wb = __builtin_amdgcn_exp2f(m2 - mm);
    sum = sum * wa + sum2 * wb;
#pragma unroll
    for (int dt = 0; dt < 4; ++dt) o[dt] = o[dt] * wa + o2[dt] * wb;
    attn_store(Z + (size_t)tq * D + hh * 64, o, sum, lane);
    LDS_SYNC_ALL();
}

__device__ __forceinline__ const float* ldp(const unsigned long long* tab, int k) {
    const unsigned long long v = __hip_atomic_load(tab + k, __ATOMIC_RELAXED, __HIP_MEMORY_SCOPE_WORKGROUP);
    const unsigned lo = __builtin_amdgcn_readfirstlane((unsigned)v), hi = __builtin_amdgcn_readfirstlane((unsigned)(v >> 32));
    return (const float*)(((unsigned long long)hi << 32) | lo);
}

#define XB_TMO      128
#define XB_XCNT(j)  (256  + 64 * (j))
#define XB_XSUB(j)  (1280 + 64 * (j))
#define XB_XGEN(j)  (2304 + 64 * (j))
#define XB_TOP      3328
#define XB_TOPGEN   3392
#define XCD_BAR_WORDS 3456
#define XB_SPIN_CAP (1u << 18)
__device__ __forceinline__ unsigned xb_ld(unsigned* p)              { return __hip_atomic_load(p, __ATOMIC_RELAXED, __HIP_MEMORY_SCOPE_AGENT); }
__device__ __forceinline__ unsigned xb_add(unsigned* p, unsigned v) { return __hip_atomic_fetch_add(p, v, __ATOMIC_RELAXED, __HIP_MEMORY_SCOPE_AGENT); }
__device__ __forceinline__ unsigned xb_xcc_id() { return (unsigned)__builtin_amdgcn_s_getreg((3 << 11) | 20) & 0xFu; }
#define XB_SPIN(cond, bar) do { unsigned _sp = 0; while (cond) { __builtin_amdgcn_s_sleep(1); \
    if ((++_sp & 255u) == 0u) { if (xb_ld(&(bar)[XB_TMO])) break; if (_sp > XB_SPIN_CAP) { atomicAdd(&(bar)[XB_TMO], 1u); break; } } } } while (0)
struct XcdBarrier { unsigned* bar; unsigned x; volatile LAS unsigned* st; };
__device__ __forceinline__ XcdBarrier xcd_barrier_post(unsigned* bar, volatile LAS unsigned* st) {
    XcdBarrier b; b.bar = bar; b.x = xb_xcc_id(); b.st = st;
    if (threadIdx.x == 0) (void)xb_add(&bar[XB_XCNT(b.x)], 1u);
    return b;
}
__device__ __forceinline__ void xcd_barrier_complete(unsigned* bar, unsigned x, unsigned& nloc, unsigned& nx) {
    const unsigned G = gridDim.x * gridDim.y * gridDim.z;
    unsigned sum, cnt, mine, sp = 0u;
    for (;;) {
        sum = 0u; cnt = 0u; mine = 0u;
#pragma unroll
        for (unsigned j = 0; j < 16; ++j) { const unsigned c = xb_ld(&bar[XB_XCNT(j)]); sum += c; cnt += (c > 0u) ? 1u : 0u; mine = (j == x) ? c : mine; }
        if (sum == G) break;
        __builtin_amdgcn_s_sleep(1);
        if ((++sp & 255u) == 0u) { if (xb_ld(&bar[XB_TMO])) break; if (sp > XB_SPIN_CAP) { atomicAdd(&bar[XB_TMO], 1u); break; } }
    }
    nloc = mine > 0u ? mine : 1u; nx = cnt > 0u ? cnt : 1u;
}
__device__ __forceinline__ void xcd_barrier(const XcdBarrier& b) {
    asm volatile("s_waitcnt vmcnt(0)" ::: "memory");
    __syncthreads();
    if (threadIdx.x == 0) {
        unsigned* bar = b.bar;
        __builtin_amdgcn_s_waitcnt(0);
        unsigned nloc = b.st[0], nx = b.st[1];
        if (nloc == 0u) { xcd_barrier_complete(bar, b.x, nloc, nx); b.st[0] = nloc; b.st[1] = nx; }
        const unsigned old = xb_add(&bar[XB_XSUB(b.x)], 1u);
        const unsigned gen = old / nloc;
        if (old + 1u == (gen + 1u) * nloc) {
            __builtin_amdgcn_fence(__ATOMIC_RELEASE, "agent");
            asm volatile("s_waitcnt vmcnt(0)" ::: "memory");
            const unsigned og = xb_add(&bar[XB_TOP], 1u);
            const unsigned tg = og / nx;
            if (og + 1u == (tg + 1u) * nx) xb_add(&bar[XB_TOPGEN], 1u);
            else XB_SPIN(xb_ld(&bar[XB_TOPGEN]) == tg, bar);
            __builtin_amdgcn_fence(__ATOMIC_ACQUIRE, "agent");
            xb_add(&bar[XB_XGEN(b.x)], 1u);
            asm volatile("s_waitcnt vmcnt(0)" ::: "memory");
        } else {
            XB_SPIN(xb_ld(&bar[XB_XGEN(b.x)]) == gen, bar);
            __builtin_amdgcn_fence(__ATOMIC_ACQUIRE, "agent");
            asm volatile("s_waitcnt vmcnt(0)" ::: "memory");
        }
    }
    __syncthreads();
}
struct Args { const float* in[33]; float* out; unsigned char* ws; int ph_lo, ph_hi; };

__global__ void __launch_bounds__(NTHR) fwd_megakernel(Args args) {
    extern __shared__ __attribute__((aligned(16))) unsigned char lds_raw[];
    LAS unsigned char* lds = (LAS unsigned char*)lds_raw;
    cg::grid_group grid = cg::this_grid();
    const int wave = __builtin_amdgcn_readfirstlane((int)threadIdx.x >> 6);
    const int G = gridDim.x, bx = blockIdx.x;
    const int vcu = (G % 8 == 0) ? (bx % 8) * (G / 8) + bx / 8 : bx;
    const int gw = vcu * NWAVES + wave, NGW = G * NWAVES;
    const int NGT = G * NTHR;
#define PHASE_IDS const int lane = lane_id(), tid = wave * 64 + lane, gtid = vcu * NTHR + tid; (void)gtid; (void)tid;
    unsigned char* ws = args.ws;
    float* out = args.out;
    unsigned long long* tab = (unsigned long long*)(ws + WS_TAB) + (size_t)blockIdx.x * 64;
    if (threadIdx.x == 0) {
#pragma unroll
        for (int k = 0; k < 33; ++k) tab[k] = (unsigned long long)args.in[k];
    }
    { const float* rp_ = args.in[20]; LAS float* rl_ = (LAS float*)(lds + LDS_RPB); for (int i = threadIdx.x; i < 8 * 465; i += NTHR) rl_[i] = rp_[i]; }
    volatile LAS unsigned* bst = (volatile LAS unsigned*)(lds + 131072);
    if (threadIdx.x < 8) bst[threadIdx.x] = 0u;
    asm volatile("s_waitcnt vmcnt(0) lgkmcnt(0)" ::: "memory");
    __syncthreads();
    XcdBarrier xbar; xbar.bar = (unsigned*)(ws + WS_BAR); xbar.x = 0; xbar.st = bst;
    if (args.ph_hi - args.ph_lo > 1) xbar = xcd_barrier_post((unsigned*)(ws + WS_BAR), bst);
    if (args.ph_hi > 1000) grid.sync();
    float* MODS = (float*)(ws + WS_MODS); f32x2* LPOW = (f32x2*)(ws + WS_LPOW); f32x2* BBAR = (f32x2*)(ws + WS_BBAR); float* KTAB = (float*)(ws + WS_KTAB);
    bf16* KC = (bf16*)(ws + WS_KC); bf16* VTC = (bf16*)(ws + WS_VTC);
    bf16* WIN0 = (bf16*)(ws + WS_WIN0); bf16* WOUT0 = (bf16*)(ws + WS_WOUT0); bf16* W1_0 = (bf16*)(ws + WS_W1_0); bf16* W2_0 = (bf16*)(ws + WS_W2_0);
    bf16* WIN1 = (bf16*)(ws + WS_WIN1); bf16* WOUT1 = (bf16*)(ws + WS_WOUT1); bf16* W1_1 = (bf16*)(ws + WS_W1_1); bf16* W2_1 = (bf16*)(ws + WS_W2_1);
    bf16* GLUT = (bf16*)(ws + WS_GLUT); bf16* BMAT = (bf16*)(ws + WS_BMAT); bf16* FMAT = (bf16*)(ws + WS_FMAT);
    bf16* H = (bf16*)(ws + WS_H); float* FBUF = (float*)(ws + WS_H);
    bf16* HID = (bf16*)(ws + WS_R); bf16* PROJ0 = (bf16*)(ws + WS_R); bf16* QKV = (bf16*)(ws + WS_R);
    bf16* Z = (bf16*)(ws + WS_Z); bf16* ABUF = (bf16*)(ws + WS_ABUF); bf16* YBUF = (bf16*)(ws + WS_YBUF);
    bf16* VTP = (bf16*)(ws + WS_VTP); bf16* VTS = (bf16*)(ws + WS_VTS);
    float* XBUF = (float*)(ws + WS_XBUF); unsigned* PCNT = (unsigned*)(ws + WS_BAR) + CNT_OFF_WORDS;
    float* X = out;

    const int lo = args.ph_lo, hi = args.ph_hi;
#ifndef PHMASK
#define PHMASK 0x7ffff
#endif
#define IN(k) (((PHMASK >> (k)) & 1) && lo <= (k) && (k) < hi)
#ifndef REPMASK
#define REPMASK 0
#endif
#define REP(k) for (int rep_ = 0; rep_ < (((REPMASK >> (k)) & 1) + 1); ++rep_)
#define SEAM2(k, k2) do { if (IN(k) && IN(k2)) xcd_barrier(xbar); } while (0)
#define SEAM(k) do { if (IN(k) && IN((k) + 1)) xcd_barrier(xbar); } while (0)

    if (IN(0)) REP(0) { PHASE_IDS
        const float* ab_w_in = ldp(tab, 14);
        const float* ab_w_out = ldp(tab, 18);
        const float* mlp_w1 = ldp(tab, 12);
        const float* mlp_w2 = ldp(tab, 13);
        LAS float* scr = (LAS float*)(lds + wave * 16384);
        constexpr int I0 = 1024, I1 = I0 + 256, I2 = I1 + 2048, I3 = I2 + 2048;
        for (int it = gw; it < I3; it += NGW) {
            if (it < I0) tr_item(ab_w_in, 2048, WIN0, 1024, scr, it, lane);
            else if (it < I1) tr_item(ab_w_out + (size_t)512 * 1024, 1024, WOUT0 + 512, 1024, scr, it - I0, lane);
            else if (it < I2) tr_item(mlp_w1, 4096, W1_0, 1024, scr, it - I1, lane);
            else tr_item(mlp_w2, 1024, W2_0, 4096, scr, it - I2, lane);
        }
        __syncthreads();
        {
            const float* ada_w = ldp(tab, 10); const float* ada_b = ldp(tab, 11); const float* cvec = ldp(tab, 2); const float* c_ctx = ldp(tab, 7);
            LAS float* sl = (LAS float*)lds;
            LAS float* red = (LAS float*)(lds + 32768);
            if (vcu < 192) {
                for (int i = tid; i < 5 * 1024; i += NTHR) { const float c = i < 4096 ? cvec[i] : c_ctx[i - 4096]; sl[i] = c * sigmoidf_(c); }
                __syncthreads();
                for (int it = vcu; it < 192; it += G) {
                    const int layer = it / 96, n = (it % 96) * 64 + (tid & 63), kc = tid >> 6;
                    const float* w = ada_w + (size_t)layer * 1024 * 6144 + (size_t)(kc * 128) * 6144 + n;
                    float a0 = 0.f, a1 = 0.f, a2 = 0.f, a3 = 0.f, a4 = 0.f;
#pragma unroll 32
                    for (int k = 0; k < 128; ++k) {
                        const int kk = kc * 128 + k; const float wv = w[(size_t)k * 6144];
                        a0 += sl[kk] * wv; a1 += sl[1024 + kk] * wv; a2 += sl[2048 + kk] * wv; a3 += sl[3072 + kk] * wv; a4 += sl[4096 + kk] * wv;
                    }
                    red[(kc * 5 + 0) * 64 + (tid & 63)] = a0; red[(kc * 5 + 1) * 64 + (tid & 63)] = a1; red[(kc * 5 + 2) * 64 + (tid & 63)] = a2;
                    red[(kc * 5 + 3) * 64 + (tid & 63)] = a3; red[(kc * 5 + 4) * 64 + (tid & 63)] = a4;
                    __syncthreads();
                    if (tid < 320) { const int cnd = tid >> 6, col = tid & 63; float s = 0.f;
#pragma unroll
                        for (int q = 0; q < 8; ++q) s += red[(q * 5 + cnd) * 64 + col];
                        const int nn = (it % 96) * 64 + col;
                        MODS[(layer * 5 + cnd) * 6144 + nn] = s + ada_b[layer * 6144 + nn]; }
                    __syncthreads();
                }
            }
        }
        {
            const float* log_step = ldp(tab, 23); const float* lam_re = ldp(tab, 21); const float* lam_im = ldp(tab, 22);
            const float* ssm_b_re = ldp(tab, 24); const float* ssm_b_im = ldp(tab, 25);
            for (int i = gtid; i < 2 * 32 * 17 * 64; i += NGT) {
                const int p = i & 63, d = (i >> 6) % 17, dg = i / (64 * 17);
                const float st = fast_exp(log_step[dg]);
                LPOW[i] = lam_pow(lam_re[dg * 64 + p], lam_im[dg * 64 + p], st, d);
            }
            for (int i = gtid; i < 2 * 32 * 64 * 16; i += NGT) {
                const int dgp = i >> 4, dg = dgp >> 6;
                const float st = fast_exp(log_step[dg]);
                const f32x2 lam = (f32x2){lam_re[dgp], lam_im[dgp]};
                const f32x2 z = lam * st;
                f32x2 phi;
                if (z.x * z.x + z.y * z.y < 0.25f) {
                    f32x2 acc = (f32x2){1.f, 0.f};
#pragma unroll
                    for (int n = 12; n >= 2; --n) { acc = cmul(acc, z) * (1.0f / (float)n); acc.x += 1.0f; }
                    phi = acc * st;
                } else {
                    const f32x2 L = lam_pow(lam.x, lam.y, st, 1);
                    const f32x2 num = (f32x2){L.x - 1.0f, L.y}; const float den = 1.0f / (lam.x * lam.x + lam.y * lam.y);
                    phi = (f32x2){(num.x * lam.x + num.y * lam.y) * den, (num.y * lam.x - num.x * lam.y) * den};
                }
                BBAR[i] = cmul(phi, (f32x2){ssm_b_re[i], ssm_b_im[i]});
            }
        }
        {
            const float* pool_w = ldp(tab, 15); const float* pool_scale = ldp(tab, 16);
            for (int i = gtid; i < 128 * 1024; i += NGT) { const int n = i & 1023, k0 = (i >> 10) * 4, gq = k0 >> 7, c = k0 & 127;
                const float* pw = pool_w + ((size_t)gq * 128 + c) * 128; const float* ps = pool_scale + gq * 128; const float* wo = ab_w_out + (size_t)(gq * 128) * 1024 + n;
                float a0 = 0.f, a1 = 0.f, a2 = 0.f, a3 = 0.f;
#pragma unroll 32
                for (int d = 0; d < 128; ++d) { const float wv = ps[d] * wo[(size_t)d * 1024]; a0 += pw[d] * wv; a1 += pw[128 + d] * wv; a2 += pw[256 + d] * wv; a3 += pw[384 + d] * wv; }
                u32x2 w; w.x = cvt_pk_bf16(a0, a1); w.y = cvt_pk_bf16(a2, a3);
                *(u32x2*)(WOUT0 + (size_t)n * 1024 + k0) = w; }
        }
    }
    SEAM(0);

    if (IN(1)) REP(1) { PHASE_IDS
        const float* x_prompt = ldp(tab, 0);
        const float* x_sample = ldp(tab, 1);
        const float* norm1_g = ldp(tab, 8);
        rms_mod_rows(x_prompt, x_sample - (size_t)NP * D, H, norm1_g, MODS, 0, gw, NGW, lane);
    }
    SEAM(1);

    if (IN(2)) REP(2) {
        pg8::Gemm g{H, WIN0, 1024, 1024, 1024}; pg8::Sched S; S.init(48, 8, G, bx, 0);
        pg8::EpiStore<0> E{PROJ0, 2048};
        pg8::gemm_phase(lds, wave, g, S, E);
        if (bx >= 128) {
            const float* ssm_c_re = ldp(tab, 26); const float* ssm_c_im = ldp(tab, 27);
            const int sid = (bx - 128) * NTHR + wave * 64 + lane_id();
            if (sid < 64 * 256) {
                const int gi = sid & 15, go = (sid >> 4) & 15, dg = sid >> 8;
                const float* cr = ssm_c_re + ((size_t)dg * 16 + go) * 64; const float* ci = ssm_c_im + ((size_t)dg * 16 + go) * 64;
                const f32x2* lp = LPOW + ((size_t)dg * 17 + 1) * 64; const f32x2* bb = BBAR + (size_t)dg * 64 * 16 + gi;
                float a[16];
#pragma unroll
                for (int d = 0; d < 16; ++d) a[d] = 0.f;
#pragma unroll 2
                for (int p = 0; p < 64; ++p) { f32x2 v = cmul((f32x2){cr[p], ci[p]}, bb[p * 16]); const f32x2 L = lp[p];
#pragma unroll
                    for (int d = 0; d < 16; ++d) { a[d] += v.x; v = cmul(v, L); } }
#pragma unroll
                for (int d = 0; d < 16; ++d) KTAB[(((size_t)dg * 16 + d) * 16 + go) * 16 + gi] = a[d];
            }
        }
    }
    SEAM(2);

    if (IN(3)) REP(3) { PHASE_IDS
        const float* conv_w = ldp(tab, 17);

        for (int it = gtid; it < NTOK * 128; it += NGT) {
            int r, cv;
            if (it < NTOK * 64) { const int gq = it / (NTOK * 16), rem = it - gq * (NTOK * 16); r = rem >> 4; cv = gq * 16 + (rem & 15); }
            else { const int i2 = it - NTOK * 64; r = i2 >> 6; cv = 64 + (i2 & 63); }
            int sb, T, t;
            if (r < NP) { sb = r & ~255; T = 256; t = r & 255; } else { const int rs = r - NP; sb = NP + (rs & ~2047); T = 2048; t = rs & 2047; }
            float o[8];
            if (cv < 64) {
                const int gq = cv >> 4, hw = 1 << gq; const int l0 = t - hw < 0 ? 0 : t - hw, h1 = t + hw > T ? T : t + hw;
                float a[8];
#pragma unroll
                for (int q = 0; q < 8; ++q) a[q] = 0.f;
                const bf16* pb = PROJ0 + (size_t)sb * 2048 + cv * 8;
#define POOL_WIN(HW) { u32x4 w_[2 * HW]; _Pragma("unroll") for (int k = 0; k < 2 * HW; ++k) { int tt = t - HW + k; const bool ok = tt >= l0 && tt < h1; tt = ok ? tt : t; w_[k] = *(const u32x4*)(pb + (size_t)tt * 2048); if (!ok) w_[k] = (u32x4){0u, 0u, 0u, 0u}; } \
                    _Pragma("unroll") for (int k = 0; k < 2 * HW; ++k) { float f[8]; unpack8(w_[k], f); _Pragma("unroll") for (int q = 0; q < 8; ++q) a[q] += f[q]; } }
                if (gq == 0) POOL_WIN(1) else if (gq == 1) POOL_WIN(2) else if (gq == 2) POOL_WIN(4) else POOL_WIN(8)
#undef POOL_WIN
                float sf[8]; unpack8(*(const u32x4*)(pb + (size_t)t * 2048), sf);
                const float ic = 1.0f / (float)(h1 - l0);
#pragma unroll
                for (int q = 0; q < 8; ++q) o[q] = a[q] * ic - sf[q];
                *(u32x4*)(Z + (size_t)r * D + cv * 8) = pack8(o);
            } else {
                const int ch0 = (cv - 64) * 8;
                float bg[8]; unpack8(*(const u32x4*)(PROJ0 + (size_t)r * 2048 + 512 + ch0), bg);
#pragma unroll
                for (int q = 0; q < 8; ++q) o[q] = 0.f;
#pragma unroll
                for (int j = 0; j < 3; ++j) { const int tt = t + j - 1;
                    if (tt >= 0 && tt < T) { float cg8[8], vv[8]; const bf16* pr = PROJ0 + (size_t)(sb + tt) * 2048 + ch0;
                        unpack8(*(const u32x4*)(pr + 1024), cg8); unpack8(*(const u32x4*)(pr + 1536), vv);
                        const f32x4 w0 = *(const f32x4*)(conv_w + j * 512 + ch0), w1 = *(const f32x4*)(conv_w + j * 512 + ch0 + 4);
#pragma unroll
                        for (int q = 0; q < 4; ++q) { o[q] += w0[q] * cg8[q] * vv[q]; o[q + 4] += w1[q] * cg8[q + 4] * vv[q + 4]; } } }
#pragma unroll
                for (int q = 0; q < 8; ++q) o[q] *= bg[q];
                *(u32x4*)(Z + (size_t)r * D + 512 + ch0) = pack8(o);
            }
        }
    }
    SEAM(3);

    if (IN(4)) REP(4) {
        const float* x_prompt = ldp(tab, 0);
        const float* x_sample = ldp(tab, 1);

        pg8::Gemm g{Z, WOUT0, 1024, 1024, 1024}; pg8::Sched S; S.init(48, 4, G, bx, 3);
        pg8::EpiResGateNorm E{x_prompt, x_sample, X, MODS + 2 * 1024, ldp(tab, 9), MODS, 3, H, XBUF, PCNT + 0 * 48 * 64, lds + LDS_XOFF, (pg8::bf16_t*)(ws + WS_XB)};
        pg8::gemm_phase(lds, wave, g, S, E);
    }
    SEAM2(4, 6);
    if (IN(6)) REP(6) {
        pg8::Gemm g{H, W1_0, 1024, 1024, 1024}; pg8::Sched S; S.init(48, 16, G, bx, 0);
        pg8::EpiStore<1> E{HID, 4096};
        pg8::gemm_phase(lds, wave, g, S, E);
    }
    SEAM(6);
    if (IN(7)) REP(7) {
        pg8::Gemm g{HID, W2_0, 4096, 4096, 4096}; pg8::Sched S; S.init(48, 4, G, bx, 3);
        pg8::EpiResGateNorm E{nullptr, nullptr, X, MODS + 5 * 1024, ldp(tab, 8) + 1024, MODS + 5 * 6144, 0, H, XBUF + (size_t)1 * NTOK * 4, PCNT + 1 * 48 * 64, lds + LDS_XOFF, (pg8::bf16_t*)(ws + WS_XB)};
        pg8::gemm_phase(lds, wave, g, S, E);
        if (bx >= 192) {
            const float* mlp_w1 = ldp(tab, 12); const float* mlp_w2 = ldp(tab, 13); const float* cd_w_in = ldp(tab, 19); const float* cd_w_out = ldp(tab, 31); const float* glu_w = ldp(tab, 29);
            LAS float* scr = (LAS float*)(lds + wave * 16384); const int lane = lane_id();
            constexpr int J0 = 1024, J1 = J0 + 512, J2 = J1 + 128;
            for (int it = (bx - 192) * NWAVES + wave; it < J2; it += 64 * NWAVES) {
                if (it < J0) tr_item(cd_w_in, 2048, WIN1, 1024, scr, it, lane);
                else if (it < J1) tr_item(cd_w_out, 1024, WOUT1, 1024, scr, it - J0, lane);
                else tr_item(glu_w, 512, GLUT, 512, scr, it - J1, lane);
            }
            const float* ssm_c_re = ldp(tab, 26); const float* ssm_c_im = ldp(tab, 27); const float* ssm_d = ldp(tab, 28);
            const int sid = (bx - 192) * NTHR + wave * 64 + lane;
#pragma unroll 4
            for (int i = sid; i < 32 * 256 * 128; i += 64 * NTHR) {
                const int k = (i & 127) * 2, n = (i >> 7) & 255, gg = i >> 15, j = k >> 4, gi = k & 15, dir = n >> 7, p = (n & 127) >> 1, ri = n & 1;
                const int dg = dir * 32 + gg, e = dir == 0 ? 15 - j : j;
                const f32x2 L = LPOW[((size_t)dg * 17 + e) * 64 + p];
                const f32x2 v0 = cmul(L, BBAR[((size_t)dg * 64 + p) * 16 + gi]), v1 = cmul(L, BBAR[((size_t)dg * 64 + p) * 16 + gi + 1]);
                *(unsigned*)(FMAT + ((size_t)gg * 256 + n) * 512 + k) = cvt_pk_bf16(ri ? v0.y : v0.x, ri ? v1.y : v1.x);
            }
#pragma unroll 4
            for (int i = sid; i < 32 * 256 * 128; i += 64 * NTHR) {
                const int kk = (i & 127) * 2, n = (i >> 7) & 255, gg = i >> 15, t = n >> 4, go = n & 15, dir = kk >> 7, p = (kk & 127) >> 1;
                const int dg = dir * 32 + gg, e = dir == 0 ? t + 1 : 16 - t;
                const size_t ci = ((size_t)dg * 16 + go) * 64 + p;
                const f32x2 v = cmul((f32x2){ssm_c_re[ci], ssm_c_im[ci]}, LPOW[((size_t)dg * 17 + e) * 64 + p]);
                *(unsigned*)(BMAT + ((size_t)gg * 256 + n) * 512 + 256 + kk) = cvt_pk_bf16(v.x, -v.y);
            }
#pragma unroll 4
            for (int i = sid; i < 32 * 256 * 128; i += 64 * NTHR) {
                const int k = (i & 127) * 2, n = (i >> 7) & 255, gg = i >> 15, j = k >> 4, gi = k & 15, t = n >> 4, go = n & 15;
                float v0 = 0.f, v1 = 0.f;
                if (t >= j) { const float* kt = KTAB + (((size_t)(0 * 32 + gg) * 16 + (t - j)) * 16 + go) * 16 + gi; v0 += kt[0]; v1 += kt[1]; }
                if (j >= t) { const float* kt = KTAB + (((size_t)(1 * 32 + gg) * 16 + (j - t)) * 16 + go) * 16 + gi; v0 += kt[0]; v1 += kt[1]; }
                if (j == t) { const float dd = ssm_d[gg * 16 + go]; if (go == gi) v0 += dd; if (go == gi + 1) v1 += dd; }
                *(unsigned*)(BMAT + ((size_t)gg * 256 + n) * 512 + k) = cvt_pk_bf16(v0, v1);
            }
            {
                const float* cache_k = ldp(tab, 3); const float* cache_v = ldp(tab, 4);
                for (int i = sid; i < 4 * 8 * 256 * 64 / 2; i += 64 * NTHR) { const f32x2 v = *(const f32x2*)(cache_k + 2 * (size_t)i); ((unsigned*)KC)[i] = cvt_pk_bf16(v.x, v.y); }
                for (int i = sid; i < 4 * 8 * 64 * 256 / 2; i += 64 * NTHR) { const int d = i & 63, l2 = (i >> 6) & 127, bh = i >> 13;
                    const float a = cache_v[((size_t)bh * 256 + 2 * l2) * 64 + d], b = cache_v[((size_t)bh * 256 + 2 * l2 + 1) * 64 + d];
                    *(unsigned*)(VTC + ((size_t)(bh * 64 + d)) * VPP + 2 * l2) = cvt_pk_bf16(a, b); }
            }
        }
    }
    SEAM2(7, 9);
    if (IN(9)) REP(9) {
        { pg8::Gemm g{H, WIN1, 1024, 1024, 1024}; pg8::Sched S; S.init(48, 6, G, bx, 1);
          pg8::EpiProj1 E{QKV, ABUF, out + O_K};
          pg8::gemm_phase(lds, wave, g, S, E); }
        { pg8::Gemm g{WIN1 + (size_t)1024 * 1024, H, 1024, 1024, 1024}; pg8::Sched S; S.init(2, 48, G, (bx + G - 32) % G, 0);
          pg8::EpiVT E{VTP, VTS, out + O_V};
          pg8::gemm_phase(lds, wave, g, S, E); }
        if (bx >= 128) {
            const float* mlp_w1 = ldp(tab, 12); const float* mlp_w2 = ldp(tab, 13);
            LAS float* scr = (LAS float*)(lds + wave * 16384); const int lane = lane_id();
            for (int it = (bx - 128) * NWAVES + wave; it < 4096; it += 128 * NWAVES) {
                if (it < 2048) tr_item(mlp_w1 + (size_t)1024 * 4096, 4096, W1_1, 1024, scr, it, lane);
                else tr_item(mlp_w2 + (size_t)4096 * 1024, 1024, W2_1, 4096, scr, it - 2048, lane);
            }
        }
    }
    SEAM2(9, 12);

#define ATTN_QUEUE(pi, jb, jn) do { \
    const int xq_ = (int)(xb_xcc_id() & 7u); unsigned* ctr_ = QCTR + ((pi) * 8 + xq_) * 16; \
    volatile LAS unsigned* qw_ = (volatile LAS unsigned*)(lds + 131072 + 64); \
    for (;;) { \
        __syncthreads(); \
        if (threadIdx.x == 0) qw_[0] = __hip_atomic_fetch_add(ctr_, 8u, __ATOMIC_RELAXED, __HIP_MEMORY_SCOPE_AGENT); \
        __syncthreads(); \
        const int f_ = (int)qw_[0]; \
        if (f_ >= (jn)) break; \
        const int j_ = (jb) + f_ + wave; \
        if (f_ + wave < (jn)) { \
        const int id = j_ < 256 ? xq_ * 256 + j_ : 2048 + xq_ * 512 + (j_ - 256); \
        const int ll = lane_id(); \
        const int l16 = ll & 15; \
        if (id < 2048) { \
            const int bh = id >> 4, qt = id & 15, b = bh >> 3, hh = bh & 7; \
            const int tq = b * 256 + qt * 16 + l16; \
            attn_unit<false>(QKV + (size_t)tq * QP + hh * 64, QKV + (size_t)(b * 256) * QP + 512 + hh * 64, VTP + (size_t)(bh * 64) * VPP, \
                             nullptr, nullptr, (const LAS float*)nullptr, 0, 0, 0, 0, Z + (size_t)tq * D + hh * 64, ll, lds + wave * 16384); \
        } else { \
            const int i2 = id - 2048, cb = i2 & 3, r = (i2 >> 2) & 31, bh = i2 >> 7, b = bh >> 3, hh = bh & 7; \
            int r0 = r - 4; r0 = r0 < 0 ? 0 : (r0 > 24 ? 24 : r0); \
            int s0 = cb * 16 - 8; s0 = s0 < 0 ? 0 : (s0 > 32 ? 32 : s0); \
            const int tb = NP + b * 2048, tq = tb + r * 64 + cb * 16 + l16; \
            attn_unit<true>(QKV + (size_t)tq * QP + hh * 64, QKV + (size_t)(tb + r0 * 64 + s0) * QP + 512 + hh * 64, \
                            VTS + (size_t)(bh * 64) * VSP + r0 * 64 + s0, KC + (size_t)bh * 256 * 64, VTC + (size_t)bh * 64 * VPP, \
                            rpb_l + hh * 465, r, r0, s0, cb, Z + (size_t)tq * D + hh * 64, ll, lds + wave * 16384); \
        } } \
    } } while (0)
    constexpr int AQ0 = 368, AQ1 = 184, AQ2 = 768 - AQ0 - AQ1;
    unsigned* QCTR = (unsigned*)(ws + WS_BAR) + 3584;
    const LAS float* rpb_l = (const LAS float*)(lds + LDS_RPB);
    if (IN(12)) REP(12) {
        { int kf = 256; asm volatile("" : "+s"(kf)); pg8::Gemm g{ABUF, FMAT, 512, 512, kf}; pg8::Sched S; S.init(96, 1, G, bx, 2);
          pg8::EpiF E{FBUF};
          pg8::gemm_phase(lds, wave, g, S, E); }
        asm volatile("s_waitcnt vmcnt(0)" ::: "memory");
        __syncthreads();
        if (bx < 96) {
            const float* st_re = ldp(tab, 5); const float* st_im = ldp(tab, 6);
            const int gg = bx / 3, ui = bx % 3, tid = wave * 64 + lane_id();
            const int nseq = ui == 0 ? 2048 : 256;
            for (int sq = tid; sq < nseq; sq += NTHR) {
                const int p = sq & 63, dir = (sq >> 6) & 1, bb = ui == 0 ? (sq >> 7) : 16 + (ui - 1) * 2 + (sq >> 7);
            const int nch = bb < 16 ? 16 : 128, cb0 = bb < 16 ? bb * 16 : 256 + (bb - 16) * 128;
            const f32x2 L16 = LPOW[((size_t)(dir * 32 + gg) * 17 + 16) * 64 + p];
            f32x2 S = (f32x2){0.f, 0.f};
            if (bb >= 16) { const size_t si = ((size_t)((bb - 16) * 2 + dir) * 32 + gg) * 64 + p; S = (f32x2){st_re[si], st_im[si]}; }
            f32x2 fa[16], fb[16];
#define SCAN_LOAD(dst, q0) { _Pragma("unroll") for (int u = 0; u < 16; ++u) { const int c = dir == 0 ? (q0) + u : nch - 1 - (q0) - u; dst[u] = *(const f32x2*)(FBUF + ((size_t)gg * 768 + cb0 + c) * 256 + dir * 128 + p * 2); } }
#define SCAN_STEP(src_, q0) { _Pragma("unroll") for (int u = 0; u < 16; ++u) { const int c = dir == 0 ? (q0) + u : nch - 1 - (q0) - u; \
                    ((unsigned*)ABUF)[(((size_t)gg * 768 + cb0 + c) * 512 + 256 + dir * 128 + p * 2) >> 1] = cvt_pk_bf16(S.x, S.y); S = cmul(L16, S) + src_[u]; } }
            SCAN_LOAD(fa, 0);
            for (int q0 = 0; q0 < nch; q0 += 32) {
                if (q0 + 16 < nch) SCAN_LOAD(fb, q0 + 16);
                SCAN_STEP(fa, q0);
                if (q0 + 16 < nch) { if (q0 + 32 < nch) SCAN_LOAD(fa, q0 + 32); SCAN_STEP(fb, q0 + 16); }
            }
#undef SCAN_LOAD
#undef SCAN_STEP
            if (bb < 16) { const size_t oi = ((size_t)(bb * 2 + dir) * 32 + gg) * 64 + p; out[O_SRE + oi] = S.x; out[O_SIM + oi] = S.y; }
            }
            asm volatile("s_waitcnt vmcnt(0)" ::: "memory");
            __syncthreads();
        }
        { pg8::Gemm g{ABUF, BMAT, 512, 512, 512}; pg8::Sched S; S.init(96, 1, G, bx, 2);
          pg8::EpiY E{YBUF};
          pg8::gemm_phase(lds, wave, g, S, E); }
        if (G == 256) {
            if (bx >= 96) {
                ctx_block_unit(vcu, QKV, VTP, Z, lds, wave, lane_id());
                const int jq = ((bx - 96) & 7) * 20 + ((bx - 96) >> 3);
                na_block_unit(2 * jq, QKV, VTS, KC, VTC, rpb_l, Z, lds, wave, lane_id());
                na_block_unit(2 * jq + 1, QKV, VTS, KC, VTC, rpb_l, Z, lds, wave, lane_id());
            }
        } else {
            for (int bu = vcu; bu < 768; bu += G) {
                const int ln = lane_id();
                if (bu < 256) ctx_block_unit(bu, QKV, VTP, Z, lds, wave, ln);
                else na_block_unit(bu - 256, QKV, VTS, KC, VTC, rpb_l, Z, lds, wave, ln);
            }
        }
    }
    SEAM(12);
    if (IN(13)) REP(13) {
        const float* glu_b = ldp(tab, 30);

        pg8::Gemm g{YBUF, GLUT, 512, 512, 512}; pg8::Sched S; S.init(48, 2, G, bx, 0);
        pg8::EpiGLU E{YBUF, Z, glu_b};
        pg8::gemm_phase(lds, wave, g, S, E);
        if (G == 256 && bx >= 96) {
            const int jq = ((bx - 96) & 7) * 20 + ((bx - 96) >> 3);
            na_block_unit(320 + jq, QKV, VTS, KC, VTC, rpb_l, Z, lds, wave, lane_id());
            if (jq < 32) na_block_unit(480 + jq, QKV, VTS, KC, VTC, rpb_l, Z, lds, wave, lane_id());
        }
        if (G == 256 && bx < 96) ctx_block_unit(vcu, QKV, VTP, Z, lds, wave, lane_id());
    }
    SEAM(13);
    if (IN(14)) REP(14) {
        pg8::Gemm g{Z, WOUT1, 1024, 1024, 1024}; pg8::Sched S; S.init(48, 4, G, bx, 3);
        pg8::EpiResGateNorm E{nullptr, nullptr, X, MODS + 5 * 6144 + 2 * 1024, ldp(tab, 9) + 1024, MODS + 5 * 6144, 3, H, XBUF + (size_t)2 * NTOK * 4, PCNT + 2 * 48 * 64, lds + LDS_XOFF, (pg8::bf16_t*)(ws + WS_XB)};
        pg8::gemm_phase(lds, wave, g, S, E);
    }
    SEAM2(14, 16);
    if (IN(16)) REP(16) {
        pg8::Gemm g{H, W1_1, 1024, 1024, 1024}; pg8::Sched S; S.init(48, 16, G, bx, 0);
        pg8::EpiStore<1> E{HID, 4096};
        pg8::gemm_phase(lds, wave, g, S, E);
    }
    SEAM(16);
    if (IN(17)) REP(17) {
        pg8::Gemm g{HID, W2_1, 4096, 4096, 4096}; pg8::Sched S; S.init(48, 4, G, bx, 3);
        pg8::EpiResGateNorm E{nullptr, nullptr, X, MODS + 5 * 6144 + 5 * 1024, ldp(tab, 32), MODS, 0, nullptr, XBUF + (size_t)3 * NTOK * 4, PCNT + 3 * 48 * 64, lds + LDS_XOFF, (pg8::bf16_t*)(ws + WS_XB)};
        pg8::gemm_phase(lds, wave, g, S, E);
    }
#undef IN
#undef SEAM
#undef SEAM2
}

extern "C" void kernel_launch(void* const* d_in, const int* in_sizes, int n_in, void* d_out, int out_size, void* d_ws, size_t ws_size, hipStream_t stream) {
    static int grid = 0;
    if (grid == 0) {
        if (n_in != 33 || ws_size < WS_END) { fprintf(stderr, "kernel_launch: unexpected n_in %d / ws_size %zu\n", n_in, ws_size); grid = -1; return; }
        int dev = 0, cus = 0, per_cu = 0;
        hipGetDevice(&dev);
        hipDeviceGetAttribute(&cus, hipDeviceAttributeMultiprocessorCount, dev);
        if (hipFuncSetAttribute((const void*)fwd_megakernel, hipFuncAttributeMaxDynamicSharedMemorySize, LDS_BYTES) != hipSuccess) { fprintf(stderr, "kernel_launch: hipFuncSetAttribute failed\n"); grid = -1; return; }
        if (hipOccupancyMaxActiveBlocksPerMultiprocessor(&per_cu, (const void*)fwd_megakernel, NTHR, LDS_BYTES) != hipSuccess || per_cu < 1) { fprintf(stderr, "kernel_launch: occupancy query gave %d\n", per_cu); per_cu = 1; (void)hipGetLastError(); }
        grid = cus;
        fprintf(stderr, "kernel_launch: cus %d per_cu %d grid %d\n", cus, per_cu, grid);
    }
    if (grid < 0) return;
    Args a{};
    for (int i = 0; i < 33; ++i) a.in[i] = (const float*)d_in[i];
    a.out = (float*)d_out; a.ws = (unsigned char*)d_ws;
#if MK_N_LAUNCHES == 1
    if (hipMemsetAsync((char*)d_ws + WS_BAR, 0, 65536, stream) != hipSuccess) { fprintf(stderr, "kernel_launch: memset of barrier words failed\n"); return; }
    a.ph_lo = 0; a.ph_hi = NPHASES;
    void* kargs[] = {&a};
    hipError_t e = hipLaunchCooperativeKernel((const void*)fwd_megakernel, dim3(grid), dim3(NTHR), kargs, LDS_BYTES, stream);
    if (e != hipSuccess) fprintf(stderr, "cooperative launch failed: %s (grid %d)\n", hipGetErrorString(e), grid);
#else
    for (int ph = 0; ph < NPHASES; ++ph) {
        a.ph_lo = ph; a.ph_hi = ph + 1;
        hipLaunchKernelGGL(fwd_megakernel, dim3(grid), dim3(NTHR), LDS_BYTES, stream, a);
    }
#endif
}
```

```cpp
#include <hip/hip_runtime.h>
#include <hip/hip_cooperative_groups.h>
#include <cstdio>
#include <cstdint>
namespace cg = cooperative_groups;

#ifndef MK_N_LAUNCHES
#define MK_N_LAUNCHES 1
#endif

#define LAS __attribute__((address_space(3)))
typedef unsigned short bf16;
typedef short bf16x8 __attribute__((ext_vector_type(8)));
typedef float f32x4 __attribute__((ext_vector_type(4)));
typedef float f32x2 __attribute__((ext_vector_type(2)));
typedef unsigned u32x4 __attribute__((ext_vector_type(4)));
typedef unsigned u32x2 __attribute__((ext_vector_type(2)));

constexpr int D = 1024, NP = 4096, NS = 8192, NTOK = 12288, FF = 4096;
constexpr int NTHR = 512, NWAVES = 8;
constexpr float EPS = 1e-6f;
constexpr int LDS_BYTES = 131072 + 256 + 8192 + 15360;
constexpr int LDS_XOFF = 131072 + 256, LDS_RPB = LDS_XOFF + 8192;
constexpr int NPHASES = 19;
constexpr int QP = 1664, VPP = 384, VSP = 2176;

constexpr size_t MiB = 1u << 20;
constexpr size_t WS_MODS = 0;
constexpr size_t WS_LPOW = 256 * 1024;
constexpr size_t WS_BBAR = 1 * MiB;
constexpr size_t WS_KTAB = 2 * MiB;
constexpr size_t WS_KC = 3 * MiB;
constexpr size_t WS_VTC = 216 * MiB;
constexpr size_t WS_WIN0 = 5 * MiB, WS_WOUT0 = 9 * MiB, WS_W1_0 = 11 * MiB, WS_W2_0 = 19 * MiB;
constexpr size_t WS_WIN1 = 27 * MiB, WS_WOUT1 = 31 * MiB, WS_W1_1 = 33 * MiB, WS_W2_1 = 41 * MiB;
constexpr size_t WS_GLUT = 49 * MiB;
constexpr size_t WS_BMAT = 50 * MiB;
constexpr size_t WS_FMAT = 58 * MiB;
constexpr size_t WS_H = 66 * MiB;
constexpr size_t WS_R = 90 * MiB;
constexpr size_t WS_Z = WS_R + 48 * MiB;
constexpr size_t WS_ABUF = WS_R + 72 * MiB;
constexpr size_t WS_YBUF = 186 * MiB;
constexpr size_t WS_VTP = 198 * MiB;
constexpr size_t WS_VTS = 204 * MiB;
constexpr size_t WS_TAB = 213 * MiB;
constexpr size_t WS_BAR = 214 * MiB;
constexpr size_t WS_XBUF = 215 * MiB;
constexpr size_t WS_XB = 218 * MiB;
constexpr size_t WS_END = 242 * MiB;
constexpr int CNT_OFF_WORDS = 4096;

constexpr size_t O_K = (size_t)NTOK * D, O_V = O_K + 2097152, O_SRE = O_V + 2097152, O_SIM = O_SRE + 65536;

__device__ __forceinline__ unsigned cvt_pk_bf16(float lo, float hi) { unsigned r; asm volatile("v_cvt_pk_bf16_f32 %0, %1, %2" : "=v"(r) : "v"(lo), "v"(hi)); return r; }
__device__ __forceinline__ float bf_lo(unsigned u) { return __uint_as_float(u << 16); }
__device__ __forceinline__ float bf_hi(unsigned u) { return __uint_as_float(u & 0xffff0000u); }
__device__ __forceinline__ float wave_sum(float v) {
#pragma unroll
    for (int o = 1; o < 64; o <<= 1) v += __shfl_xor(v, o);
    return v;
}
__device__ __forceinline__ int lane_id() { int l; asm volatile("v_mbcnt_lo_u32_b32 %0, -1, 0\n\tv_mbcnt_hi_u32_b32 %0, -1, %0" : "=v"(l)); return l; }
__device__ __forceinline__ float fast_exp(float x) { return __builtin_amdgcn_exp2f(x * 1.44269504089f); }
__device__ __forceinline__ float sigmoidf_(float x) { return 1.0f / (1.0f + fast_exp(-x)); }
__device__ __forceinline__ float gelu_tanh(float y) {
    const float a = 0.7978845608f * (y + 0.044715f * y * y * y);
    const float t = 1.0f - 2.0f / (1.0f + fast_exp(2.0f * a));
    return 0.5f * y * (1.0f + t);
}
__device__ __forceinline__ void unpack8(const u32x4 u, float (&f)[8]) {
    f[0] = bf_lo(u.x); f[1] = bf_hi(u.x); f[2] = bf_lo(u.y); f[3] = bf_hi(u.y); f[4] = bf_lo(u.z); f[5] = bf_hi(u.z); f[6] = bf_lo(u.w); f[7] = bf_hi(u.w);
}
__device__ __forceinline__ u32x4 pack8(const float (&f)[8]) {
    u32x4 w; w.x = cvt_pk_bf16(f[0], f[1]); w.y = cvt_pk_bf16(f[2], f[3]); w.z = cvt_pk_bf16(f[4], f[5]); w.w = cvt_pk_bf16(f[6], f[7]); return w;
}
__device__ __forceinline__ int cond_of_row(int r) { return r < NP ? 4 : ((r - NP) >> 11); }

namespace pg8 {
typedef unsigned short bf16_t;
constexpr int BM = 256, BK = 64, HALF = 128, HTB = HALF * BK * 2, STAGE_BYTES = 8 * HTB, NXCD = 8, WGM = 8;
__host__ __device__ __forceinline__ int lds_byte(int r, int c) { const int st = (r >> 4) * 2 + (c >> 5), rr = r & 15, cc = c & 31, ob = rr * 64 + cc * 2; return st * 1024 + (ob ^ (((ob >> 9) & 1) << 5)); }
__host__ __device__ __forceinline__ void stage_rc(int b, int& R, int& C) { const int st = b / 1024, sb = b % 1024, swz = sb ^ (((sb >> 9) & 1) << 5); R = (st >> 1) * 16 + swz / 64; C = (st & 1) * 32 + (swz % 64) / 2; }
__host__ __device__ __forceinline__ int perm32(int rho) { const int n = rho >> 4, i = rho & 15; return 8 * (i >> 2) + 4 * n + (i & 3); }

struct Unit { int pm, pn; };
struct Gemm { const bf16_t* A; const bf16_t* Bt; int lda, ldb, K; };

struct Sched {
    int nM, nN, nwg, G, c, mode;
    __device__ void init(int nM_, int nN_, int G_, int c_, int mode_) { nM = nM_; nN = nN_; nwg = nM * nN; G = G_; c = c_; mode = mode_; }
    __device__ bool next(int i, Unit& u) const {
        const long L = (long)i * G + c; if (L >= nwg) return false;
        if (mode == 2) { u.pm = (int)L; u.pn = (int)L / 3; return true; }
        if (mode == 3) { const int x = (int)L & 7, k = (int)L >> 3; u.pm = x + 8 * (k >> 2); u.pn = k & 3; return true; }
        int wgid = (int)L; { const int q = nwg / NXCD, r = nwg % NXCD, xcd = wgid % NXCD, off = wgid / NXCD; wgid = (xcd < r ? xcd * (q + 1) : r * (q + 1) + (xcd - r) * q) + off; }
        const int nig = WGM * nN, gid = wgid / nig, fm = gid * WGM, gsz = (nM - fm) < WGM ? (nM - fm) : WGM;
        u.pm = fm + ((wgid % nig) % gsz); u.pn = (wgid % nig) / gsz;
        if (mode == 1 && u.pn >= 4) u.pn += 2;
        return true;
    }
};

template <class T, class = void> struct is_fused { static constexpr bool value = false; };
template <class T> struct is_fused<T, decltype((void)T::FUSED)> { static constexpr bool value = true; };
template <class Epi>
__device__ __forceinline__ void gemm_phase(LAS unsigned char* lds, const int wid, const Gemm g, const Sched& S, const Epi& E) {
    const int lane = lane_id(), tid = wid * 64 + lane, wr = wid >> 2, wc = wid & 3, fr = lane & 15, fq = lane >> 4;
    const int K = g.K, nt = K / BK;
    unsigned voffA[2], voffB[2];
#pragma unroll
    for (int i = 0; i < 2; ++i) { int R, C; stage_rc(tid * 16 + i * 8192, R, C); const int Rb = (R & ~31) + perm32(R & 31);
        voffA[i] = (unsigned)(R * g.lda + C) * 2u; voffB[i] = (unsigned)(Rb * g.ldb + C) * 2u; }
    const size_t kstep = (size_t)(BK * 2);
    const size_t hA = (size_t)HALF * g.lda * 2, hB = (size_t)HALF * g.ldb * 2;
    const size_t tA = 2 * hA, tB = 2 * hB;
    const unsigned ldsw = (unsigned)wid * 1024u;
    const int aoff = lds_byte(wr * 64 + fr, fq * 8), boff = lds_byte(wc * 32 + fr, fq * 8);
#define PG8_SA(b, h) (((b) * 2 + (h)) * HTB)
#define PG8_SB(b, h) ((4 + (b) * 2 + (h)) * HTB)
#define PG8_STAGE(bufoff, gbase, voff) do { _Pragma("unroll") for (int _i = 0; _i < 2; ++_i) \
        __builtin_amdgcn_global_load_lds((const unsigned*)((const char*)(gbase) + (voff)[_i]), (LAS unsigned*)(lds + (bufoff) + ldsw + _i * 8192), 16, 0, 0); } while (0)
#define PG8_LDA(dst, b, h) do { _Pragma("unroll") for (int m = 0; m < 4; ++m) _Pragma("unroll") for (int k = 0; k < 2; ++k) dst[m][k] = *(const LAS bf16x8*)(lds + PG8_SA(b, h) + aoff + m * 2048 + k * 1024); } while (0)
#define PG8_LDB(dst, b, h) do { _Pragma("unroll") for (int n = 0; n < 2; ++n) _Pragma("unroll") for (int k = 0; k < 2; ++k) dst[n][k] = *(const LAS bf16x8*)(lds + PG8_SB(b, h) + boff + n * 2048 + k * 1024); } while (0)
#define PG8_MMA(ai, bj, At, Bt) do { __builtin_amdgcn_s_setprio(1); _Pragma("unroll") for (int m = 0; m < 4; ++m) _Pragma("unroll") for (int n = 0; n < 2; ++n) _Pragma("unroll") for (int k = 0; k < 2; ++k) \
        acc[ai][bj][m][n] = __builtin_amdgcn_mfma_f32_16x16x32_bf16(Bt[n][k], At[m][k], acc[ai][bj][m][n], 0, 0, 0); __builtin_amdgcn_s_setprio(0); } while (0)
#define PG8_WAIT_V(n) asm volatile("s_waitcnt vmcnt(" #n ")" ::: "memory")
#define PG8_WAIT_L(n) asm volatile("s_waitcnt lgkmcnt(" #n ")" ::: "memory")
#define PG8_BAR __builtin_amdgcn_s_barrier()
#define PG8_SCHED __builtin_amdgcn_sched_barrier(0)
    Unit cur, nxt; int ui = 0;
    if (!S.next(0, cur)) return;
    f32x4 acc[2][2][4][2];
#pragma unroll
    for (int a = 0; a < 2; ++a)
#pragma unroll
        for (int b = 0; b < 2; ++b)
#pragma unroll
            for (int m = 0; m < 4; ++m)
#pragma unroll
                for (int n = 0; n < 2; ++n) acc[a][b][m][n] = (f32x4){0.f, 0.f, 0.f, 0.f};
    bf16x8 At[4][2], B0[2][2], B1[2][2];
    const char* cA = (const char*)g.A + (size_t)cur.pm * tA; const char* cB = (const char*)g.Bt + (size_t)cur.pn * tB;
    PG8_STAGE(PG8_SB(0, 0), cB, voffB); PG8_STAGE(PG8_SB(0, 1), cB + hB, voffB); PG8_STAGE(PG8_SA(0, 0), cA, voffA); PG8_STAGE(PG8_SA(0, 1), cA + hA, voffA);
    if (wr == 1) PG8_BAR;
    PG8_WAIT_V(2); PG8_BAR;
    PG8_STAGE(PG8_SB(1, 0), cB + kstep, voffB); PG8_STAGE(PG8_SA(1, 0), cA + kstep, voffA); PG8_STAGE(PG8_SB(1, 1), cB + hB + kstep, voffB);
    PG8_WAIT_V(6); PG8_BAR;
    for (;;) {
        const bool has_next = S.next(ui + 1, nxt);
        const char* nA = has_next ? (const char*)g.A + (size_t)nxt.pm * tA : cA; const char* nB = has_next ? (const char*)g.Bt + (size_t)nxt.pn * tB : cB;
        for (int t = 0; t < nt; t += 2) {
            const bool last = (t == nt - 2);
            const char* a1 = cA + (size_t)(t + 1) * kstep;
            const char* a2 = last ? nA : cA + (size_t)(t + 2) * kstep; const char* b2 = last ? nB : cB + (size_t)(t + 2) * kstep;
            const char* a3 = a2 + kstep; const char* b3 = b2 + kstep;
            PG8_LDB(B0, 0, 0); PG8_LDB(B1, 0, 1); PG8_SCHED; PG8_LDA(At, 0, 0); PG8_STAGE(PG8_SA(1, 1), a1 + hA, voffA);
            PG8_WAIT_V(8); PG8_WAIT_L(0); PG8_BAR; PG8_MMA(0, 0, At, B0); PG8_MMA(0, 1, At, B1); PG8_BAR; PG8_SCHED;
            PG8_LDA(At, 0, 1); PG8_STAGE(PG8_SB(0, 0), b2, voffB); PG8_STAGE(PG8_SB(0, 1), b2 + hB, voffB); PG8_STAGE(PG8_SA(0, 0), a2, voffA);
            PG8_WAIT_V(8); PG8_WAIT_L(0); PG8_BAR; PG8_MMA(1, 0, At, B0); PG8_MMA(1, 1, At, B1); PG8_BAR; PG8_SCHED;
            PG8_LDB(B0, 1, 0); PG8_LDB(B1, 1, 1); PG8_SCHED; PG8_LDA(At, 1, 0); PG8_STAGE(PG8_SA(0, 1), a2 + hA, voffA);
            PG8_WAIT_V(8); PG8_WAIT_L(0); PG8_BAR; PG8_MMA(0, 0, At, B0); PG8_MMA(0, 1, At, B1); PG8_BAR; PG8_SCHED;
            PG8_LDA(At, 1, 1); PG8_STAGE(PG8_SB(1, 0), b3, voffB); PG8_STAGE(PG8_SB(1, 1), b3 + hB, voffB); PG8_STAGE(PG8_SA(1, 0), a3, voffA);
            PG8_WAIT_V(8); PG8_WAIT_L(0); PG8_BAR; PG8_MMA(1, 0, At, B0); PG8_MMA(1, 1, At, B1); PG8_BAR; PG8_SCHED;
        }
        if (wr == 0) PG8_BAR;
        if constexpr (is_fused<Epi>::value) E.fused(acc, cur, wr, wc, fr, fq, wid, lane); else E(acc, cur, wr, wc, fr, fq);
        if (!has_next) break;
#pragma unroll
        for (int a = 0; a < 2; ++a)
#pragma unroll
            for (int b = 0; b < 2; ++b)
#pragma unroll
                for (int m = 0; m < 4; ++m)
#pragma unroll
                    for (int n = 0; n < 2; ++n) acc[a][b][m][n] = (f32x4){0.f, 0.f, 0.f, 0.f};
        cur = nxt; cA = nA; cB = nB; ++ui;
        if (wr == 1) PG8_BAR;
    }
    PG8_WAIT_V(0);
    PG8_BAR;
#undef PG8_SA
#undef PG8_SB
#undef PG8_STAGE
#undef PG8_LDA
#undef PG8_LDB
#undef PG8_MMA
#undef PG8_WAIT_V
#undef PG8_WAIT_L
#undef PG8_BAR
#undef PG8_SCHED
}

template <int ACT  > struct EpiStore {
    bf16_t* O; int ldc;
    __device__ __forceinline__ void operator()(const f32x4 (&acc)[2][2][4][2], const Unit& u, int wr, int wc, int fr, int fq) const {
        const int row0 = u.pm * BM + wr * 64 + fr, col0 = u.pn * BM + wc * 32 + 8 * fq;
#pragma unroll
        for (int ai = 0; ai < 2; ++ai)
#pragma unroll
            for (int m = 0; m < 4; ++m) { bf16_t* rowp = O + (size_t)(row0 + ai * HALF + m * 16) * ldc + col0;
#pragma unroll
                for (int bj = 0; bj < 2; ++bj) { f32x4 v0 = acc[ai][bj][m][0], v1 = acc[ai][bj][m][1];
                    if (ACT == 1) {
#pragma unroll
                        for (int i = 0; i < 4; ++i) { const float a = fmaxf(v0[i], 0.f), b = fmaxf(v1[i], 0.f); v0[i] = a * a; v1[i] = b * b; } }
                    u32x4 w; w.x = cvt_pk_bf16(v0[0], v0[1]); w.y = cvt_pk_bf16(v0[2], v0[3]); w.z = cvt_pk_bf16(v1[0], v1[1]); w.w = cvt_pk_bf16(v1[2], v1[3]);
                    *(u32x4*)(rowp + bj * HALF) = w; } }
    }
};
struct EpiResGate {
    const float* xp; const float* xs; float* out; const float* gates;
    __device__ __forceinline__ void operator()(const f32x4 (&acc)[2][2][4][2], const Unit& u, int wr, int wc, int fr, int fq) const {
        const int rb = u.pm * BM; const float* gate = gates + cond_of_row(rb) * 6144;
        const float* base = xp ? (rb < NP ? xp : xs - (size_t)NP * D) : out;
        const int row0 = rb + wr * 64 + fr, col0 = u.pn * BM + wc * 32 + 8 * fq;
        f32x4 gv[2][2];
#pragma unroll
        for (int bj = 0; bj < 2; ++bj)
#pragma unroll
            for (int n = 0; n < 2; ++n) gv[bj][n] = *(const f32x4*)(gate + col0 + bj * HALF + 4 * n);
#pragma unroll
        for (int ai = 0; ai < 2; ++ai)
#pragma unroll
            for (int m = 0; m < 4; ++m) { const size_t ro = (size_t)(row0 + ai * HALF + m * 16) * D + col0;
#pragma unroll
                for (int bj = 0; bj < 2; ++bj)
#pragma unroll
                    for (int n = 0; n < 2; ++n) { const f32x4 b = *(const f32x4*)(base + ro + bj * HALF + 4 * n);
                        *(f32x4*)(out + ro + bj * HALF + 4 * n) = b + gv[bj][n] * acc[ai][bj][m][n]; } }
    }
};
struct EpiResGateNorm {
    static constexpr bool FUSED = true;
    const float* xp; const float* xs; float* out; const float* gates;
    const float* gam; const float* modn; int sidx; bf16_t* Hn;
    float* xbuf; unsigned* cnt; LAS unsigned char* l2; bf16_t* XB;
    __device__ __forceinline__ void fused(f32x4 (&acc)[2][2][4][2], const Unit& u, int wr, int wc, int fr, int fq, int wid, int lane) const {
        LAS float* P = (LAS float*)l2;
        LAS float* S = (LAS float*)(l2 + 4096);
        const int rb = u.pm * BM; const int cnd = cond_of_row(rb); const float* gate = gates + cnd * 6144;
        const float* base = xp ? (rb < NP ? xp : xs - (size_t)NP * D) : out;
        const int row0 = rb + wr * 64 + fr, col0 = u.pn * BM + wc * 32 + 8 * fq;
        {
            f32x4 gv[2][2];
#pragma unroll
            for (int bj = 0; bj < 2; ++bj)
#pragma unroll
                for (int n = 0; n < 2; ++n) gv[bj][n] = *(const f32x4*)(gate + col0 + bj * HALF + 4 * n);
#pragma unroll
            for (int am = 0; am < 4; ++am) {
                const int ai = am >> 1, m0 = (am & 1) * 2;
                f32x4 bb[2][2][2];
#pragma unroll
                for (int mm = 0; mm < 2; ++mm)
#pragma unroll
                    for (int bj = 0; bj < 2; ++bj)
#pragma unroll
                        for (int n = 0; n < 2; ++n) if (xp) bb[mm][bj][n] = *(const f32x4*)(base + (size_t)(row0 + ai * HALF + (m0 + mm) * 16) * D + col0 + bj * HALF + 4 * n);
                if (!xp) {
                    u32x4 rb4[2][2];
#pragma unroll
                    for (int mm = 0; mm < 2; ++mm)
#pragma unroll
                        for (int bj = 0; bj < 2; ++bj) rb4[mm][bj] = *(const u32x4*)(XB + (size_t)(row0 + ai * HALF + (m0 + mm) * 16) * D + col0 + bj * HALF);
#pragma unroll
                    for (int mm = 0; mm < 2; ++mm)
#pragma unroll
                        for (int bj = 0; bj < 2; ++bj) { float f[8]; unpack8(rb4[mm][bj], f);
                            bb[mm][bj][0] = (f32x4){f[0], f[1], f[2], f[3]}; bb[mm][bj][1] = (f32x4){f[4], f[5], f[6], f[7]}; }
                }
#pragma unroll
                for (int mm = 0; mm < 2; ++mm) { const int m = m0 + mm; const size_t ro = (size_t)(row0 + ai * HALF + m * 16) * D + col0; float s = 0.f;
#pragma unroll
                    for (int bj = 0; bj < 2; ++bj)
#pragma unroll
                        for (int n = 0; n < 2; ++n) {
                            const f32x4 v = bb[mm][bj][n] + gv[bj][n] * acc[ai][bj][m][n]; acc[ai][bj][m][n] = v;
                            s += (v[0] * v[0] + v[1] * v[1]) + (v[2] * v[2] + v[3] * v[3]); }
                    s += __shfl_xor(s, 16); s += __shfl_xor(s, 32);
                    if (fq == 0) P[(ai * HALF + wr * 64 + m * 16 + fr) * 4 + wc] = s; }
            }
        }
        asm volatile("s_waitcnt lgkmcnt(0)" ::: "memory"); __builtin_amdgcn_s_barrier(); asm volatile("" ::: "memory");
        const int prow = wid * 32 + (lane & 31);
        if (lane < 32) {
            const float tot = (P[prow * 4 + 0] + P[prow * 4 + 1]) + (P[prow * 4 + 2] + P[prow * 4 + 3]);
            __hip_atomic_store(xbuf + ((size_t)(rb + prow) * 4 + u.pn), tot, __ATOMIC_RELAXED, __HIP_MEMORY_SCOPE_AGENT);
        }
        asm volatile("s_waitcnt vmcnt(0)" ::: "memory");
        if (lane == 0) __hip_atomic_fetch_add(cnt + 64 * u.pm, 1u, __ATOMIC_RELAXED, __HIP_MEMORY_SCOPE_AGENT);
        if (Hn) {
#pragma unroll
            for (int ai = 0; ai < 2; ++ai)
#pragma unroll
                for (int m = 0; m < 4; ++m) { bf16_t* op = XB + (size_t)(row0 + ai * HALF + m * 16) * D + col0;
#pragma unroll
                    for (int bj = 0; bj < 2; ++bj) { const f32x4 v0 = acc[ai][bj][m][0], v1 = acc[ai][bj][m][1];
                        u32x4 w; w.x = cvt_pk_bf16(v0[0], v0[1]); w.y = cvt_pk_bf16(v0[2], v0[3]); w.z = cvt_pk_bf16(v1[0], v1[1]); w.w = cvt_pk_bf16(v1[2], v1[3]);
                        *(u32x4*)(op + bj * HALF) = w; } }
        }
        if (wid == 0) {
            unsigned sp = 0;
            for (;;) {
                if ((unsigned)__builtin_amdgcn_readfirstlane(__hip_atomic_load(cnt + 64 * u.pm, __ATOMIC_RELAXED, __HIP_MEMORY_SCOPE_AGENT)) >= 32u) break;
                if (++sp > (1u << 20)) break;
                __builtin_amdgcn_s_sleep(2);
            }
            __builtin_amdgcn_fence(__ATOMIC_ACQUIRE, "agent");
        }
        asm volatile("s_waitcnt vmcnt(0) lgkmcnt(0)" ::: "memory"); __builtin_amdgcn_s_barrier(); asm volatile("" ::: "memory");
        if (lane < 32) {
            const float* slot = xbuf + (size_t)(rb + prow) * 4; float tot = 0.f;
#pragma unroll
            for (int t = 0; t < 4; ++t) tot += __hip_atomic_load(slot + t, __ATOMIC_RELAXED, __HIP_MEMORY_SCOPE_AGENT);
            S[prow] = 1.0f / sqrtf(tot * (1.0f / D) + EPS);
        }
        asm volatile("s_waitcnt vmcnt(0) lgkmcnt(0)" ::: "memory"); __builtin_amdgcn_s_barrier(); asm volatile("" ::: "memory");
        const float* sh = modn + cnd * 6144 + sidx * 1024; const float* sc = sh + 1024;
#pragma unroll
        for (int bj = 0; bj < 2; ++bj) {
            const int c = col0 + bj * HALF;
            f32x4 g0 = *(const f32x4*)(gam + c), g1 = *(const f32x4*)(gam + c + 4), h0 = (f32x4){0.f, 0.f, 0.f, 0.f}, h1 = h0;
            if (Hn) { g0 = g0 * (*(const f32x4*)(sc + c) + 1.0f); g1 = g1 * (*(const f32x4*)(sc + c + 4) + 1.0f); h0 = *(const f32x4*)(sh + c); h1 = *(const f32x4*)(sh + c + 4); }
#pragma unroll
            for (int ai = 0; ai < 2; ++ai)
#pragma unroll
                for (int m = 0; m < 4; ++m) { const int rl = ai * HALF + wr * 64 + m * 16 + fr; const float rstd = S[rl];
                    const f32x4 o0 = acc[ai][bj][m][0] * rstd * g0 + h0, o1 = acc[ai][bj][m][1] * rstd * g1 + h1;
                    if (Hn) { u32x4 w; w.x = cvt_pk_bf16(o0[0], o0[1]); w.y = cvt_pk_bf16(o0[2], o0[3]); w.z = cvt_pk_bf16(o1[0], o1[1]); w.w = cvt_pk_bf16(o1[2], o1[3]);
                        *(u32x4*)(Hn + (size_t)(rb + rl) * D + c) = w; }
                    else { float* o = out + (size_t)(rb + rl) * D + c; *(f32x4*)o = o0; *(f32x4*)(o + 4) = o1; } }
        }
    }
};
struct EpiProj1 {
    bf16_t* QKV; bf16_t* ABUF; float* outK;
    __device__ __forceinline__ void operator()(const f32x4 (&acc)[2][2][4][2], const Unit& u, int wr, int wc, int fr, int fq) const {
        const int row0 = u.pm * BM + wr * 64 + fr, col0 = u.pn * BM + wc * 32 + 8 * fq;
#pragma unroll
        for (int ai = 0; ai < 2; ++ai)
#pragma unroll
            for (int m = 0; m < 4; ++m) { const int r = row0 + ai * HALF + m * 16;
#pragma unroll
                for (int bj = 0; bj < 2; ++bj) { const int c = col0 + bj * HALF; const f32x4 v0 = acc[ai][bj][m][0], v1 = acc[ai][bj][m][1];
                    u32x4 w; w.x = cvt_pk_bf16(v0[0], v0[1]); w.y = cvt_pk_bf16(v0[2], v0[3]); w.z = cvt_pk_bf16(v1[0], v1[1]); w.w = cvt_pk_bf16(v1[2], v1[3]);
                    if (u.pn < 4) {
                        *(u32x4*)(QKV + (size_t)r * QP + c) = w;
                        if (u.pn >= 2 && r < NP) { const int b = r >> 8, t = r & 255, hh = (c - 512) >> 6, d = (c - 512) & 63;
                            float* o = outK + ((size_t)((b * 8 + hh) * 256 + t)) * 64 + d; *(f32x4*)o = v0; *(f32x4*)(o + 4) = v1; }
                    } else { const int cu = c - 1536, gg = cu >> 4, gi0 = cu & 15, chunk = r >> 4, j = r & 15;
                        *(u32x4*)(ABUF + ((size_t)(gg * 768 + chunk)) * 512 + j * 16 + gi0) = w; }
                } }
    }
};
struct EpiVT {
    bf16_t* VTP; bf16_t* VTS; float* outV;
    __device__ __forceinline__ void operator()(const f32x4 (&acc)[2][2][4][2], const Unit& u, int wr, int wc, int fr, int fq) const {
        const int row0 = u.pm * BM + wr * 64 + fr, col0 = u.pn * BM + wc * 32 + 8 * fq;
#pragma unroll
        for (int ai = 0; ai < 2; ++ai)
#pragma unroll
            for (int m = 0; m < 4; ++m) { const int c = row0 + ai * HALF + m * 16, hh = c >> 6, d = c & 63;
#pragma unroll
                for (int bj = 0; bj < 2; ++bj) { const int r0 = col0 + bj * HALF; const f32x4 v0 = acc[ai][bj][m][0], v1 = acc[ai][bj][m][1];
                    u32x4 w; w.x = cvt_pk_bf16(v0[0], v0[1]); w.y = cvt_pk_bf16(v0[2], v0[3]); w.z = cvt_pk_bf16(v1[0], v1[1]); w.w = cvt_pk_bf16(v1[2], v1[3]);
                    if (r0 < NP) { const int b = r0 >> 8, t0 = r0 & 255;
                        *(u32x4*)(VTP + ((size_t)((b * 8 + hh) * 64 + d)) * VPP + t0) = w;
                        float* o = outV + ((size_t)((b * 8 + hh) * 256 + t0)) * 64 + d;
#pragma unroll
                        for (int i = 0; i < 4; ++i) { o[i * 64] = v0[i]; o[(i + 4) * 64] = v1[i]; }
                    } else { const int rs = r0 - NP, b = rs >> 11, t0 = rs & 2047;
                        *(u32x4*)(VTS + ((size_t)((b * 8 + hh) * 64 + d)) * VSP + t0) = w; }
                } }
    }
};
struct EpiF {
    float* F;
    __device__ __forceinline__ void operator()(const f32x4 (&acc)[2][2][4][2], const Unit& u, int wr, int wc, int fr, int fq) const {
        const int row0 = u.pm * BM + wr * 64 + fr, col0 = wc * 32 + 8 * fq;
#pragma unroll
        for (int ai = 0; ai < 2; ++ai)
#pragma unroll
            for (int m = 0; m < 4; ++m) { float* rowp = F + (size_t)(row0 + ai * HALF + m * 16) * 256 + col0;
#pragma unroll
                for (int bj = 0; bj < 2; ++bj) { *(f32x4*)(rowp + bj * HALF) = acc[ai][bj][m][0]; *(f32x4*)(rowp + bj * HALF + 4) = acc[ai][bj][m][1]; } }
    }
};
struct EpiY {
    bf16_t* Y;
    __device__ __forceinline__ void operator()(const f32x4 (&acc)[2][2][4][2], const Unit& u, int wr, int wc, int fr, int fq) const {
        const int gg = u.pn, row0 = u.pm * BM + wr * 64 + fr - gg * 768, col0 = wc * 32 + 8 * fq;
#pragma unroll
        for (int ai = 0; ai < 2; ++ai)
#pragma unroll
            for (int m = 0; m < 4; ++m) { const int chunk = row0 + ai * HALF + m * 16;
#pragma unroll
                for (int bj = 0; bj < 2; ++bj) { const int n = col0 + bj * HALF, t = n >> 4, go0 = n & 15; const f32x4 v0 = acc[ai][bj][m][0], v1 = acc[ai][bj][m][1];
                    u32x4 w; w.x = cvt_pk_bf16(gelu_tanh(v0[0]), gelu_tanh(v0[1])); w.y = cvt_pk_bf16(gelu_tanh(v0[2]), gelu_tanh(v0[3]));
                    w.z = cvt_pk_bf16(gelu_tanh(v1[0]), gelu_tanh(v1[1])); w.w = cvt_pk_bf16(gelu_tanh(v1[2]), gelu_tanh(v1[3]));
                    *(u32x4*)(Y + ((size_t)(chunk * 16 + t)) * 512 + gg * 16 + go0) = w; } }
    }
};
struct EpiGLU {
    const bf16_t* Y; bf16_t* Z; const float* bias;
    __device__ __forceinline__ void operator()(const f32x4 (&acc)[2][2][4][2], const Unit& u, int wr, int wc, int fr, int fq) const {
        const int row0 = u.pm * BM + wr * 64 + fr, col0 = u.pn * BM + wc * 32 + 8 * fq;
#pragma unroll
        for (int ai = 0; ai < 2; ++ai)
#pragma unroll
            for (int m = 0; m < 4; ++m) { const int r = row0 + ai * HALF + m * 16;
#pragma unroll
                for (int bj = 0; bj < 2; ++bj) { const int c = col0 + bj * HALF; const f32x4 v0 = acc[ai][bj][m][0], v1 = acc[ai][bj][m][1];
                    const u32x4 yu = *(const u32x4*)(Y + (size_t)r * 512 + c); float y[8]; unpack8(yu, y);
                    const f32x4 b0 = *(const f32x4*)(bias + c), b1 = *(const f32x4*)(bias + c + 4);
                    float o[8];
#pragma unroll
                    for (int i = 0; i < 4; ++i) { o[i] = y[i] * sigmoidf_(v0[i] + b0[i]); o[i + 4] = y[i + 4] * sigmoidf_(v1[i] + b1[i]); }
                    *(u32x4*)(Z + (size_t)r * D + 512 + c) = pack8(o); } }
    }
};
}

__device__ __forceinline__ void tr_item(const float* W, int N, bf16* WT, int ldt, LAS float* scr, int item, int lane) {
    const int nblk = N / 32, kb = item / nblk, nb = item % nblk, k0 = 64 * kb, n0 = 32 * nb;
    float tv[32];
#pragma unroll
    for (int i = 0; i < 32; ++i) tv[i] = W[(size_t)(k0 + 2 * i + (lane >> 5)) * N + n0 + (lane & 31)];
#pragma unroll
    for (int i = 0; i < 32; ++i) scr[(2 * i + (lane >> 5)) * 33 + (lane & 31)] = tv[i];
    asm volatile("s_waitcnt lgkmcnt(0)" ::: "memory");
    const int c = lane & 7;
#pragma unroll
    for (int j = 0; j < 4; ++j) { const int n = (lane >> 3) + 8 * j; const LAS float* s = scr + (8 * c) * 33 + n;
        u32x4 o; o.x = cvt_pk_bf16(s[0 * 33], s[1 * 33]); o.y = cvt_pk_bf16(s[2 * 33], s[3 * 33]); o.z = cvt_pk_bf16(s[4 * 33], s[5 * 33]); o.w = cvt_pk_bf16(s[6 * 33], s[7 * 33]);
        *(u32x4*)(WT + (size_t)(n0 + n) * ldt + k0 + 8 * c) = o; }
    asm volatile("s_waitcnt lgkmcnt(0)" ::: "memory");
}

__device__ __forceinline__ f32x2 cmul(f32x2 a, f32x2 b) { return (f32x2){a.x * b.x - a.y * b.y, a.x * b.y + a.y * b.x}; }
__device__ __forceinline__ f32x2 lam_pow(float lre, float lim, float st, int d) {
    const float mag = fast_exp(lre * st * (float)d);
    const double rev = (double)lim * (double)st * (double)d * 0.15915494309189535;
    const float fr = (float)(rev - __builtin_rint(rev));
    return (f32x2){mag * __builtin_amdgcn_cosf(fr), mag * __builtin_amdgcn_sinf(fr)};
}

__device__ __forceinline__ void rms_mod_rows(const float* xp, const float* xs_m, bf16* H, bf16* XBc, const float* gam, const float* modl, int sidx, int gw, int NGW, int lane) {
    for (int r = gw; r < NTOK; r += 2 * NGW) {
        const int r1 = r + NGW; const bool has1 = r1 < NTOK; const int r1c = has1 ? r1 : r;
        const float* xr0 = (r < NP ? xp : xs_m) + (size_t)r * D; const float* xr1 = (r1c < NP ? xp : xs_m) + (size_t)r1c * D;
        f32x4 v0[4], v1[4]; float s0 = 0.f, s1 = 0.f;
#pragma unroll
        for (int j = 0; j < 4; ++j) { v0[j] = *((const f32x4*)xr0 + lane + 64 * j); v1[j] = *((const f32x4*)xr1 + lane + 64 * j); }
#pragma unroll
        for (int j = 0; j < 4; ++j) { s0 += (v0[j].x * v0[j].x + v0[j].y * v0[j].y) + (v0[j].z * v0[j].z + v0[j].w * v0[j].w);
                                      s1 += (v1[j].x * v1[j].x + v1[j].y * v1[j].y) + (v1[j].z * v1[j].z + v1[j].w * v1[j].w); }
        const float rstd0 = 1.0f / sqrtf(wave_sum(s0) * (1.f / D) + EPS), rstd1 = 1.0f / sqrtf(wave_sum(s1) * (1.f / D) + EPS);
        const float* sh0 = modl + cond_of_row(r) * 6144 + sidx * 1024; const float* sh1 = modl + cond_of_row(r1c) * 6144 + sidx * 1024;
#pragma unroll
        for (int j = 0; j < 4; ++j) { const int c = 4 * (lane + 64 * j);
            const f32x4 g4 = *(const f32x4*)(gam + c);
            { const f32x4 s4 = *(const f32x4*)(sh0 + 1024 + c), h4 = *(const f32x4*)(sh0 + c); const f32x4 o = (v0[j] * rstd0) * g4 * (s4 + 1.0f) + h4;
              u32x2 w; w.x = cvt_pk_bf16(o.x, o.y); w.y = cvt_pk_bf16(o.z, o.w); *(u32x2*)(H + (size_t)r * D + c) = w;
              u32x2 wx; wx.x = cvt_pk_bf16(v0[j].x, v0[j].y); wx.y = cvt_pk_bf16(v0[j].z, v0[j].w); *(u32x2*)(XBc + (size_t)r * D + c) = wx; }
            if (has1) { const f32x4 s4 = *(const f32x4*)(sh1 + 1024 + c), h4 = *(const f32x4*)(sh1 + c); const f32x4 o = (v1[j] * rstd1) * g4 * (s4 + 1.0f) + h4;
              u32x2 w; w.x = cvt_pk_bf16(o.x, o.y); w.y = cvt_pk_bf16(o.z, o.w); *(u32x2*)(H + (size_t)r1 * D + c) = w;
              u32x2 wx; wx.x = cvt_pk_bf16(v1[j].x, v1[j].y); wx.y = cvt_pk_bf16(v1[j].z, v1[j].w); *(u32x2*)(XBc + (size_t)r1 * D + c) = wx; }
        }
    }
}

__device__ __forceinline__ void wait_vm(int n) {
    switch (n) {
        case 0: asm volatile("s_waitcnt vmcnt(0)" ::: "memory"); break;   case 1: asm volatile("s_waitcnt vmcnt(1)" ::: "memory"); break;
        case 2: asm volatile("s_waitcnt vmcnt(2)" ::: "memory"); break;   case 3: asm volatile("s_waitcnt vmcnt(3)" ::: "memory"); break;
        case 4: asm volatile("s_waitcnt vmcnt(4)" ::: "memory"); break;   case 5: asm volatile("s_waitcnt vmcnt(5)" ::: "memory"); break;
        case 6: asm volatile("s_waitcnt vmcnt(6)" ::: "memory"); break;   case 7: asm volatile("s_waitcnt vmcnt(7)" ::: "memory"); break;
        case 8: asm volatile("s_waitcnt vmcnt(8)" ::: "memory"); break;   case 9: asm volatile("s_waitcnt vmcnt(9)" ::: "memory"); break;
        case 10: asm volatile("s_waitcnt vmcnt(10)" ::: "memory"); break; case 11: asm volatile("s_waitcnt vmcnt(11)" ::: "memory"); break;
        case 12: asm volatile("s_waitcnt vmcnt(12)" ::: "memory"); break; case 13: asm volatile("s_waitcnt vmcnt(13)" ::: "memory"); break;
        case 14: asm volatile("s_waitcnt vmcnt(14)" ::: "memory"); break; default: asm volatile("s_waitcnt vmcnt(15)" ::: "memory"); break;
    }
}
__device__ __forceinline__ void dma16(const bf16* g, LAS unsigned char* l) { __builtin_amdgcn_global_load_lds((const unsigned*)g, (LAS unsigned*)l, 16, 0, 0); }
template <bool BIAS, int kpitchA, int rsA, int vpitchA>
__device__ __forceinline__ void attn_seg(const bf16x8 qf0, const bf16x8 qf1, const bf16* kA, const bf16* vtA, LAS unsigned char* wl,
                                         const LAS float* rpbh, int r, int r0, int s0, int cb, int lane, float& mout, float& sumout, f32x4 (&o)[4]) {
    const int l16 = lane & 15, g4 = lane >> 4;
    const LAS unsigned char* rl = wl + lane * 16;
    f32x4 s[16];
    constexpr int RK = 8;
    const bf16* kbase = kA + (size_t)((l16 >> 2) * 8 + (l16 & 3)) * kpitchA + g4 * 8;
    const bf16* kr = kbase;
#pragma unroll
    for (int t = 0; t < RK - 1; ++t) { dma16(kr, wl + t * 2048); dma16(kr + 32, wl + t * 2048 + 1024);
        kr += (size_t)((t & 1) ? (rsA - 4) : 4) * kpitchA; asm volatile("" : "+v"(kr)); }
#pragma unroll
    for (int t = 0; t < 16; ++t) {
        if (t + RK - 1 < 16) { const int tn = t + RK - 1;
            dma16(kr, wl + (tn % RK) * 2048); dma16(kr + 32, wl + (tn % RK) * 2048 + 1024);
            kr += (size_t)((tn & 1) ? (rsA - 4) : 4) * kpitchA; asm volatile("" : "+v"(kr)); }
        wait_vm(2 * ((15 - t) < (RK - 1) ? (15 - t) : (RK - 1)));
        const bf16x8 a0 = *(const LAS bf16x8*)(rl + (t % RK) * 2048), a1 = *(const LAS bf16x8*)(rl + (t % RK) * 2048 + 1024);
        f32x4 z = (f32x4){0.f, 0.f, 0.f, 0.f};
        z = __builtin_amdgcn_mfma_f32_16x16x32_bf16(a0, qf0, z, 0, 0, 0);
        s[t] = __builtin_amdgcn_mfma_f32_16x16x32_bf16(a1, qf1, z, 0, 0, 0);
        __builtin_amdgcn_sched_barrier(0);
    }
    constexpr int RV = 16;
    const bf16* vbase = vtA + (size_t)l16 * vpitchA + g4 * 8;
    asm volatile("s_waitcnt lgkmcnt(0)" ::: "memory");
    const bf16* vr = vbase;
#pragma unroll
    for (int q = 0; q < RV - 1; ++q) { dma16(vr, wl + q * 1024);
        vr += ((q & 3) == 3) ? (ptrdiff_t)rsA - (ptrdiff_t)48 * vpitchA : (ptrdiff_t)16 * vpitchA; asm volatile("" : "+v"(vr)); }
    __builtin_amdgcn_sched_barrier(0);
    float mx = -3.0e38f;
    constexpr float SC = 0.125f * 1.44269504089f, L2E = 1.44269504089f;
    if (BIAS) {
        int cidx[8];
        const int qc = cb * 16 + l16; int c0 = qc - 8; c0 = c0 < 0 ? 0 : (c0 > 48 ? 48 : c0);
#pragma unroll
        for (int e = 0; e < 8; ++e) { const int x = g4 * 8 + e, kc = s0 + x; int co = kc - qc; co = co < -15 ? -15 : (co > 15 ? 15 : co);
            cidx[e] = (kc >= c0 && kc < c0 + 16) ? (co + 15) : -1; }
#pragma unroll
        for (int t = 0; t < 16; ++t) { const int y = t >> 1; const LAS float* rp = rpbh + (r0 + y - r + 7) * 31;
#pragma unroll
            for (int i = 0; i < 4; ++i) { const int ci = cidx[(t & 1) * 4 + i];
                const float bsv = rp[ci >= 0 ? ci : 0];
                const float v = ci >= 0 ? s[t][i] * SC + bsv * L2E : -1.0e30f; s[t][i] = v; mx = fmaxf(mx, v); } }
    } else {
#pragma unroll
        for (int t = 0; t < 16; ++t)
#pragma unroll
            for (int i = 0; i < 4; ++i) { const float v = s[t][i] * SC; s[t][i] = v; mx = fmaxf(mx, v); }
    }
    mx = fmaxf(mx, __shfl_xor(mx, 16)); mx = fmaxf(mx, __shfl_xor(mx, 32));
    float sum = 0.f;
#pragma unroll
    for (int dt = 0; dt < 4; ++dt) o[dt] = (f32x4){0.f, 0.f, 0.f, 0.f};
#pragma unroll
    for (int j = 0; j < 8; ++j) {
        float p[8];
#pragma unroll
        for (int i = 0; i < 4; ++i) { p[i] = __builtin_amdgcn_exp2f(s[2 * j][i] - mx); p[4 + i] = __builtin_amdgcn_exp2f(s[2 * j + 1][i] - mx); }
#pragma unroll
        for (int i = 0; i < 8; ++i) sum += p[i];
        const bf16x8 pb = __builtin_bit_cast(bf16x8, pack8(p));
#pragma unroll
        for (int dt = 0; dt < 4; ++dt) {
            const int q = j * 4 + dt, qn = q + RV - 1;
            if (qn < 32) { dma16(vr, wl + (qn % RV) * 1024);
                vr += ((qn & 3) == 3) ? (ptrdiff_t)rsA - (ptrdiff_t)48 * vpitchA : (ptrdiff_t)16 * vpitchA; asm volatile("" : "+v"(vr)); }
            wait_vm((31 - q) < (RV - 1) ? (31 - q) : (RV - 1));
            const bf16x8 vq = *(const LAS bf16x8*)(rl + (q % RV) * 1024);
            o[dt] = __builtin_amdgcn_mfma_f32_16x16x32_bf16(vq, pb, o[dt], 0, 0, 0);
            __builtin_amdgcn_sched_barrier(0);
        }
    }
    asm volatile("s_waitcnt lgkmcnt(0)" ::: "memory");
    sum += __shfl_xor(sum, 16); sum += __shfl_xor(sum, 32);
    mout = mx; sumout = sum;
}
template <bool NA>
__device__ __forceinline__ void attn_unit(const bf16* qrow, const bf16* kA, const bf16* vtA,
                                          const bf16* kB, const bf16* vtB, const LAS float* rpbh, int r, int r0, int s0, int cb, bf16* orow, int lane, LAS unsigned char* wl) {
    const int g4 = lane >> 4;
    const bf16x8 qf0 = *(const bf16x8*)(qrow + g4 * 8), qf1 = *(const bf16x8*)(qrow + 32 + g4 * 8);
    f32x4 o[4]; float m, sum;
    if (NA) attn_seg<true, QP, 64, VSP>(qf0, qf1, kA, vtA, wl, rpbh, r, r0, s0, cb, lane, m, sum, o);
    else attn_seg<false, QP, 32, VPP>(qf0, qf1, kA, vtA, wl, rpbh, r, r0, s0, cb, lane, m, sum, o);
    if (NA) {
        f32x4 o2[4]; float m2, sum2;
        attn_seg<false, 64, 32, VPP>(qf0, qf1, kB, vtB, wl, (const LAS float*)nullptr, 0, 0, 0, 0, lane, m2, sum2, o2);
        const float mm = fmaxf(m, m2), wa = __builtin_amdgcn_exp2f(m - mm), wb = __builtin_amdgcn_exp2f(m2 - mm);
        sum = sum * wa + sum2 * wb;
#pragma unroll
        for (int dt = 0; dt < 4; ++dt) o[dt] = o[dt] * wa + o2[dt] * wb;
    }
    const float inv = 1.0f / sum;
#pragma unroll
    for (int dt = 0; dt < 4; ++dt) { u32x2 w; w.x = cvt_pk_bf16(o[dt][0] * inv, o[dt][1] * inv); w.y = cvt_pk_bf16(o[dt][2] * inv, o[dt][3] * inv);
        *(u32x2*)(orow + dt * 16 + g4 * 4) = w; }
}


__device__ __forceinline__ int kimg_f(int kidx) { return ((kidx >> 3) & 3) | (((kidx >> 1) & 1) << 2); }
__device__ __forceinline__ int kimg_off(int kidx, int c) { return kidx * 128 + ((c ^ kimg_f(kidx)) << 4); }
__device__ __forceinline__ void stage_k(LAS unsigned char* img, const bf16* g0, int pitch, int nkeys, int wave, int lane) {
    const int kin = lane >> 3, p = lane & 7;
    for (int pc = wave; pc < (nkeys >> 3); pc += NWAVES) { const int key = pc * 8 + kin, c = p ^ kimg_f(key);
        dma16(g0 + (size_t)key * pitch + c * 8, img + pc * 1024); }
}
__device__ __forceinline__ void stage_v(LAS unsigned char* img, const bf16* g0, int gpitch, int ntok, int VB, int wave, int lane) {
    const int total = 64 * VB;
    for (int pc = wave; pc * 1024 < total; pc += NWAVES) { const int o = pc * 1024 + lane * 16; int d = o / VB, w = o - d * VB;
        if (d > 63) { d = 63; w = 0; } if (w >= ntok * 2) w = 0;
        dma16(g0 + (size_t)d * gpitch + (w >> 1), img + pc * 1024); }
}
template <bool BIAS, int RS>
__device__ __forceinline__ float qk_lds(const bf16x8 qf0, const bf16x8 qf1, const LAS unsigned char* kimg, int kwin, f32x4 (&s)[16],
                                        const LAS float* rpbh, int r, int r0, int s0, int cb, int lane) {
    const int l16 = lane & 15, g4 = lane >> 4;
    const int xl = (l16 >> 2) * 8 + (l16 & 3);
#pragma unroll
    for (int t = 0; t < 16; ++t) {
        const int kidx = kwin + (t >> 1) * RS + (t & 1) * 4 + xl;
        const bf16x8 a0 = *(const LAS bf16x8*)(kimg + kimg_off(kidx, g4)), a1 = *(const LAS bf16x8*)(kimg + kimg_off(kidx, 4 + g4));
        f32x4 z = (f32x4){0.f, 0.f, 0.f, 0.f};
        z = __builtin_amdgcn_mfma_f32_16x16x32_bf16(a0, qf0, z, 0, 0, 0);
        s[t] = __builtin_amdgcn_mfma_f32_16x16x32_bf16(a1, qf1, z, 0, 0, 0);
    }
    float mx = -3.0e38f;
    constexpr float SC = 0.125f * 1.44269504089f, L2E = 1.44269504089f;
    if (BIAS) {
        int cidx[8];
        const int qc = cb * 16 + l16; int c0 = qc - 8; c0 = c0 < 0 ? 0 : (c0 > 48 ? 48 : c0);
#pragma unroll
        for (int e = 0; e < 8; ++e) { const int x = g4 * 8 + e, kc = s0 + x; int co = kc - qc; co = co < -15 ? -15 : (co > 15 ? 15 : co);
            cidx[e] = (kc >= c0 && kc < c0 + 16) ? (co + 15) : -1; }
#pragma unroll
        for (int t = 0; t < 16; ++t) { const int y = t >> 1; const LAS float* rp = rpbh + (r0 + y - r + 7) * 31;
#pragma unroll
            for (int i = 0; i < 4; ++i) { const int ci = cidx[(t & 1) * 4 + i];
                const float bsv = rp[ci >= 0 ? ci : 0];
                const float v = ci >= 0 ? s[t][i] * SC + bsv * L2E : -1.0e30f; s[t][i] = v; mx = fmaxf(mx, v); } }
    } else {
#pragma unroll
        for (int t = 0; t < 16; ++t)
#pragma unroll
            for (int i = 0; i < 4; ++i) { const float v = s[t][i] * SC; s[t][i] = v; mx = fmaxf(mx, v); }
    }
    mx = fmaxf(mx, __shfl_xor(mx, 16)); mx = fmaxf(mx, __shfl_xor(mx, 32));
    return mx;
}
template <int RS, int VB>
__device__ __forceinline__ float pv_lds(const LAS unsigned char* vimg, int kwin, const f32x4 (&s)[16], float mx, f32x4 (&o)[4], int lane) {
    const int l16 = lane & 15, g4 = lane >> 4;
    const LAS unsigned char* vb = vimg + l16 * VB + (kwin + g4 * 8) * 2;
    float sum = 0.f;
#pragma unroll
    for (int dt = 0; dt < 4; ++dt) o[dt] = (f32x4){0.f, 0.f, 0.f, 0.f};
#pragma unroll
    for (int j = 0; j < 8; ++j) {
        float p[8];
#pragma unroll
        for (int i = 0; i < 4; ++i) { p[i] = __builtin_amdgcn_exp2f(s[2 * j][i] - mx); p[4 + i] = __builtin_amdgcn_exp2f(s[2 * j + 1][i] - mx); }
#pragma unroll
        for (int i = 0; i < 8; ++i) sum += p[i];
        const bf16x8 pb = __builtin_bit_cast(bf16x8, pack8(p));
#pragma unroll
        for (int dt = 0; dt < 4; ++dt) {
            const bf16x8 vq = *(const LAS bf16x8*)(vb + dt * 16 * VB + j * RS * 2);
            o[dt] = __builtin_amdgcn_mfma_f32_16x16x32_bf16(vq, pb, o[dt], 0, 0, 0);
        }
    }
    sum += __shfl_xor(sum, 16); sum += __shfl_xor(sum, 32);
    return sum;
}
__device__ __forceinline__ void attn_store(bf16* orow, const f32x4 (&o)[4], float sum, int lane) {
    const int g4 = lane >> 4; const float inv = 1.0f / sum;
#pragma unroll
    for (int dt = 0; dt < 4; ++dt) { u32x2 w; w.x = cvt_pk_bf16(o[dt][0] * inv, o[dt][1] * inv); w.y = cvt_pk_bf16(o[dt][2] * inv, o[dt][3] * inv);
        *(u32x2*)(orow + dt * 16 + g4 * 4) = w; }
}
#define LDS_SYNC_ALL() do { asm volatile("s_waitcnt vmcnt(0) lgkmcnt(0)" ::: "memory"); __syncthreads(); } while (0)
__device__ __forceinline__ void ctx_block_unit(int id, const bf16* QKV, const bf16* VTP, bf16* Z, LAS unsigned char* lds, int wave, int lane) {
    const int bh = id >> 1, b = bh >> 3, hh = bh & 7, qt = (id & 1) * 8 + wave, l16 = lane & 15, g4 = lane >> 4;
    const int tq = b * 256 + qt * 16 + l16;
    const bf16* qrow = QKV + (size_t)tq * QP + hh * 64;
    const bf16x8 qf0 = *(const bf16x8*)(qrow + g4 * 8), qf1 = *(const bf16x8*)(qrow + 32 + g4 * 8);
    stage_k(lds, QKV + (size_t)(b * 256) * QP + 512 + hh * 64, QP, 256, wave, lane);
    stage_v(lds + 32768, VTP + (size_t)(bh * 64) * VPP, VPP, 256, 528, wave, lane);
    LDS_SYNC_ALL();
    f32x4 s[16], o[4];
    const float mx = qk_lds<false, 32>(qf0, qf1, lds, 0, s, (const LAS float*)nullptr, 0, 0, 0, 0, lane);
    const float sum = pv_lds<32, 528>(lds + 32768, 0, s, mx, o, lane);
    attn_store(Z + (size_t)tq * D + hh * 64, o, sum, lane);
    LDS_SYNC_ALL();
}
__device__ __forceinline__ void na_block_unit(int id, const bf16* QKV, const bf16* VTS, const bf16* KC, const bf16* VTC, const LAS float* rpb_l, bf16* Z, LAS unsigned char* lds, int wave, int lane) {
    const int bh = id >> 4, rp = id & 15, b = bh >> 3, hh = bh & 7, r = 2 * rp + (wave >> 2), cb = wave & 3, l16 = lane & 15, g4 = lane >> 4;
    int r0 = r - 4; r0 = r0 < 0 ? 0 : (r0 > 24 ? 24 : r0);
    int r0a = 2 * rp - 4; r0a = r0a < 0 ? 0 : (r0a > 24 ? 24 : r0a);
    int s0 = cb * 16 - 8; s0 = s0 < 0 ? 0 : (s0 > 32 ? 32 : s0);
    const int nrows = (32 - r0a) < 9 ? (32 - r0a) : 9;
    const int tb = NP + b * 2048, tq = tb + r * 64 + cb * 16 + l16;
    const bf16* qrow = QKV + (size_t)tq * QP + hh * 64;
    const bf16x8 qf0 = *(const bf16x8*)(qrow + g4 * 8), qf1 = *(const bf16x8*)(qrow + 32 + g4 * 8);
    const int kwin = (r0 - r0a) * 64 + s0;
    stage_k(lds, QKV + (size_t)(tb + r0a * 64) * QP + 512 + hh * 64, QP, nrows * 64, wave, lane);
    LDS_SYNC_ALL();
    f32x4 s[16], o[4];
    const float m1 = qk_lds<true, 64>(qf0, qf1, lds, kwin, s, rpb_l + hh * 465, r, r0, s0, cb, lane);
    LDS_SYNC_ALL();
    stage_v(lds, VTS + (size_t)(bh * 64) * VSP + r0a * 64, VSP, nrows * 64, 1168, wave, lane);
    LDS_SYNC_ALL();
    float sum = pv_lds<64, 1168>(lds, kwin, s, m1, o, lane);
    LDS_SYNC_ALL();
    stage_k(lds, KC + (size_t)bh * 256 * 64, 64, 256, wave, lane);
    stage_v(lds + 32768, VTC + (size_t)bh * 64 * VPP, VPP, 256, 528, wave, lane);
    LDS_SYNC_ALL();
    f32x4 o2[4];
    const float m2 = qk_lds<false, 32>(qf0, qf1, lds, 0, s, (const LAS float*)nullptr, 0, 0, 0, 0, lane);
    const float sum2 = pv_lds<32, 528>(lds + 32768, 0, s, m2, o2, lane);
    const float mm = fmaxf(m1, m2), wa = __builtin_amdgcn_exp2f(m1 - mm), wb = __builtin_amdgcn_exp2f(m2 - mm);
    sum = sum * wa + sum2 * wb;
#pragma unroll
    for (int dt = 0; dt < 4; ++dt) o[dt] = o[dt] * wa + o2[dt] * wb;
    attn_store(Z + (size_t)tq * D + hh * 64, o, sum, lane);
    LDS_SYNC_ALL();
}

__device__ __forceinline__ const float* ldp(const unsigned long long* tab, int k) {
    const unsigned long long v = __hip_atomic_load(tab + k, __ATOMIC_RELAXED, __HIP_MEMORY_SCOPE_WORKGROUP);
    const unsigned lo = __builtin_amdgcn_readfirstlane((unsigned)v), hi = __builtin_amdgcn_readfirstlane((unsigned)(v >> 32));
    return (const float*)(((unsigned long long)hi << 32) | lo);
}

#define XB_TMO      128
#define XB_XCNT(j)  (256  + 64 * (j))
#define XB_XSUB(j)  (1280 + 64 * (j))
#define XB_XGEN(j)  (2304 + 64 * (j))
#define XB_TOP      3328
#define XB_TOPGEN   3392
#define XCD_BAR_WORDS 3456
#define XB_SPIN_CAP (1u << 18)
__device__ __forceinline__ unsigned xb_ld(unsigned* p)              { return __hip_atomic_load(p, __ATOMIC_RELAXED, __HIP_MEMORY_SCOPE_AGENT); }
__device__ __forceinline__ unsigned xb_add(unsigned* p, unsigned v) { return __hip_atomic_fetch_add(p, v, __ATOMIC_RELAXED, __HIP_MEMORY_SCOPE_AGENT); }
__device__ __forceinline__ unsigned xb_xcc_id() { return (unsigned)__builtin_amdgcn_s_getreg((3 << 11) | 20) & 0xFu; }
#define XB_SPIN(cond, bar) do { unsigned _sp = 0; while (cond) { __builtin_amdgcn_s_sleep(1); \
    if ((++_sp & 255u) == 0u) { if (xb_ld(&(bar)[XB_TMO])) break; if (_sp > XB_SPIN_CAP) { atomicAdd(&(bar)[XB_TMO], 1u); break; } } } } while (0)
struct XcdBarrier { unsigned* bar; unsigned x; volatile LAS unsigned* st; };
__device__ __forceinline__ XcdBarrier xcd_barrier_post(unsigned* bar, volatile LAS unsigned* st) {
    XcdBarrier b; b.bar = bar; b.x = xb_xcc_id(); b.st = st;
    if (threadIdx.x == 0) (void)xb_add(&bar[XB_XCNT(b.x)], 1u);
    return b;
}
__device__ __forceinline__ void xcd_barrier_complete(unsigned* bar, unsigned x, unsigned& nloc, unsigned& nx) {
    const unsigned G = gridDim.x * gridDim.y * gridDim.z;
    unsigned sum, cnt, mine, sp = 0u;
    for (;;) {
        sum = 0u; cnt = 0u; mine = 0u;
#pragma unroll
        for (unsigned j = 0; j < 16; ++j) { const unsigned c = xb_ld(&bar[XB_XCNT(j)]); sum += c; cnt += (c > 0u) ? 1u : 0u; mine = (j == x) ? c : mine; }
        if (sum == G) break;
        __builtin_amdgcn_s_sleep(1);
        if ((++sp & 255u) == 0u) { if (xb_ld(&bar[XB_TMO])) break; if (sp > XB_SPIN_CAP) { atomicAdd(&bar[XB_TMO], 1u); break; } }
    }
    nloc = mine > 0u ? mine : 1u; nx = cnt > 0u ? cnt : 1u;
}
__device__ __forceinline__ void xcd_barrier(const XcdBarrier& b) {
    asm volatile("s_waitcnt vmcnt(0)" ::: "memory");
    __syncthreads();
    if (threadIdx.x == 0) {
        unsigned* bar = b.bar;
        __builtin_amdgcn_s_waitcnt(0);
        unsigned nloc = b.st[0], nx = b.st[1];
        if (nloc == 0u) { xcd_barrier_complete(bar, b.x, nloc, nx); b.st[0] = nloc; b.st[1] = nx; }
        const unsigned old = xb_add(&bar[XB_XSUB(b.x)], 1u);
        const unsigned gen = old / nloc;
        if (old + 1u == (gen + 1u) * nloc) {
            __builtin_amdgcn_fence(__ATOMIC_RELEASE, "agent");
            asm volatile("s_waitcnt vmcnt(0)" ::: "memory");
            const unsigned og = xb_add(&bar[XB_TOP], 1u);
            const unsigned tg = og / nx;
            if (og + 1u == (tg + 1u) * nx) xb_add(&bar[XB_TOPGEN], 1u);
            else XB_SPIN(xb_ld(&bar[XB_TOPGEN]) == tg, bar);
            __builtin_amdgcn_fence(__ATOMIC_ACQUIRE, "agent");
            xb_add(&bar[XB_XGEN(b.x)], 1u);
            asm volatile("s_waitcnt vmcnt(0)" ::: "memory");
        } else {
            XB_SPIN(xb_ld(&bar[XB_XGEN(b.x)]) == gen, bar);
            __builtin_amdgcn_fence(__ATOMIC_ACQUIRE, "agent");
            asm volatile("s_waitcnt vmcnt(0)" ::: "memory");
        }
    }
    __syncthreads();
}
struct Args { const float* in[33]; float* out; unsigned char* ws; int ph_lo, ph_hi; };

__global__ void __launch_bounds__(NTHR) fwd_megakernel(Args args) {
    extern __shared__ __attribute__((aligned(16))) unsigned char lds_raw[];
    LAS unsigned char* lds = (LAS unsigned char*)lds_raw;
    cg::grid_group grid = cg::this_grid();
    const int wave = __builtin_amdgcn_readfirstlane((int)threadIdx.x >> 6);
    const int G = gridDim.x, bx = blockIdx.x;
    const int vcu = (G % 8 == 0) ? (bx % 8) * (G / 8) + bx / 8 : bx;
    const int gw = vcu * NWAVES + wave, NGW = G * NWAVES;
    const int NGT = G * NTHR;
#define PHASE_IDS const int lane = lane_id(), tid = wave * 64 + lane, gtid = vcu * NTHR + tid; (void)gtid; (void)tid;
    unsigned char* ws = args.ws;
    float* out = args.out;
    unsigned long long* tab = (unsigned long long*)(ws + WS_TAB) + (size_t)blockIdx.x * 64;
    if (threadIdx.x == 0) {
#pragma unroll
        for (int k = 0; k < 33; ++k) tab[k] = (unsigned long long)args.in[k];
    }
    { const float* rp_ = args.in[20]; LAS float* rl_ = (LAS float*)(lds + LDS_RPB); for (int i = threadIdx.x; i < 8 * 465; i += NTHR) rl_[i] = rp_[i]; }
    volatile LAS unsigned* bst = (volatile LAS unsigned*)(lds + 131072);
    if (threadIdx.x < 8) bst[threadIdx.x] = 0u;
    asm volatile("s_waitcnt vmcnt(0) lgkmcnt(0)" ::: "memory");
    __syncthreads();
    XcdBarrier xbar; xbar.bar = (unsigned*)(ws + WS_BAR); xbar.x = 0; xbar.st = bst;
    if (args.ph_hi - args.ph_lo > 1) xbar = xcd_barrier_post((unsigned*)(ws + WS_BAR), bst);
    if (args.ph_hi > 1000) grid.sync();
    float* MODS = (float*)(ws + WS_MODS); f32x2* LPOW = (f32x2*)(ws + WS_LPOW); f32x2* BBAR = (f32x2*)(ws + WS_BBAR); float* KTAB = (float*)(ws + WS_KTAB);
    bf16* KC = (bf16*)(ws + WS_KC); bf16* VTC = (bf16*)(ws + WS_VTC);
    bf16* WIN0 = (bf16*)(ws + WS_WIN0); bf16* WOUT0 = (bf16*)(ws + WS_WOUT0); bf16* W1_0 = (bf16*)(ws + WS_W1_0); bf16* W2_0 = (bf16*)(ws + WS_W2_0);
    bf16* WIN1 = (bf16*)(ws + WS_WIN1); bf16* WOUT1 = (bf16*)(ws + WS_WOUT1); bf16* W1_1 = (bf16*)(ws + WS_W1_1); bf16* W2_1 = (bf16*)(ws + WS_W2_1);
    bf16* GLUT = (bf16*)(ws + WS_GLUT); bf16* BMAT = (bf16*)(ws + WS_BMAT); bf16* FMAT = (bf16*)(ws + WS_FMAT);
    bf16* H = (bf16*)(ws + WS_H); float* FBUF = (float*)(ws + WS_H);
    bf16* HID = (bf16*)(ws + WS_R); bf16* PROJ0 = (bf16*)(ws + WS_R); bf16* QKV = (bf16*)(ws + WS_R);
    bf16* Z = (bf16*)(ws + WS_Z); bf16* ABUF = (bf16*)(ws + WS_ABUF); bf16* YBUF = (bf16*)(ws + WS_YBUF);
    bf16* VTP = (bf16*)(ws + WS_VTP); bf16* VTS = (bf16*)(ws + WS_VTS);
    float* XBUF = (float*)(ws + WS_XBUF); unsigned* PCNT = (unsigned*)(ws + WS_BAR) + CNT_OFF_WORDS;
    float* X = out;

    const int lo = args.ph_lo, hi = args.ph_hi;
#ifndef PHMASK
#define PHMASK 0x7ffff
#endif
#define IN(k) (((PHMASK >> (k)) & 1) && lo <= (k) && (k) < hi)
#ifndef REPMASK
#define REPMASK 0
#endif
#define REP(k) for (int rep_ = 0; rep_ < (((REPMASK >> (k)) & 1) + 1); ++rep_)
#define SEAM2(k, k2) do { if (IN(k) && IN(k2)) xcd_barrier(xbar); } while (0)
#define SEAM(k) do { if (IN(k) && IN((k) + 1)) xcd_barrier(xbar); } while (0)

    if (IN(0)) REP(0) { PHASE_IDS
        const float* ab_w_in = ldp(tab, 14);
        const float* ab_w_out = ldp(tab, 18);
        const float* mlp_w1 = ldp(tab, 12);
        const float* mlp_w2 = ldp(tab, 13);
        LAS float* scr = (LAS float*)(lds + wave * 16384);
        constexpr int I0 = 1024, I1 = I0 + 256, I2 = I1 + 2048, I3 = I2 + 2048;
        for (int it = gw; it < I3; it += NGW) {
            if (it < I0) tr_item(ab_w_in, 2048, WIN0, 1024, scr, it, lane);
            else if (it < I1) tr_item(ab_w_out + (size_t)512 * 1024, 1024, WOUT0 + 512, 1024, scr, it - I0, lane);
            else if (it < I2) tr_item(mlp_w1, 4096, W1_0, 1024, scr, it - I1, lane);
            else tr_item(mlp_w2, 1024, W2_0, 4096, scr, it - I2, lane);
        }
        __syncthreads();
        {
            const float* ada_w = ldp(tab, 10); const float* ada_b = ldp(tab, 11); const float* cvec = ldp(tab, 2); const float* c_ctx = ldp(tab, 7);
            LAS float* sl = (LAS float*)lds;
            LAS float* red = (LAS float*)(lds + 32768);
            if (vcu < 192) {
                for (int i = tid; i < 5 * 1024; i += NTHR) { const float c = i < 4096 ? cvec[i] : c_ctx[i - 4096]; sl[i] = c * sigmoidf_(c); }
                __syncthreads();
                for (int it = vcu; it < 192; it += G) {
                    const int layer = it / 96, n = (it % 96) * 64 + (tid & 63), kc = tid >> 6;
                    const float* w = ada_w + (size_t)layer * 1024 * 6144 + (size_t)(kc * 128) * 6144 + n;
                    float a0 = 0.f, a1 = 0.f, a2 = 0.f, a3 = 0.f, a4 = 0.f;
#pragma unroll 32
                    for (int k = 0; k < 128; ++k) {
                        const int kk = kc * 128 + k; const float wv = w[(size_t)k * 6144];
                        a0 += sl[kk] * wv; a1 += sl[1024 + kk] * wv; a2 += sl[2048 + kk] * wv; a3 += sl[3072 + kk] * wv; a4 += sl[4096 + kk] * wv;
                    }
                    red[(kc * 5 + 0) * 64 + (tid & 63)] = a0; red[(kc * 5 + 1) * 64 + (tid & 63)] = a1; red[(kc * 5 + 2) * 64 + (tid & 63)] = a2;
                    red[(kc * 5 + 3) * 64 + (tid & 63)] = a3; red[(kc * 5 + 4) * 64 + (tid & 63)] = a4;
                    __syncthreads();
                    if (tid < 320) { const int cnd = tid >> 6, col = tid & 63; float s = 0.f;
#pragma unroll
                        for (int q = 0; q < 8; ++q) s += red[(q * 5 + cnd) * 64 + col];
                        const int nn = (it % 96) * 64 + col;
                        MODS[(layer * 5 + cnd) * 6144 + nn] = s + ada_b[layer * 6144 + nn]; }
                    __syncthreads();
                }
            }
        }
        {
            const float* log_step = ldp(tab, 23); const float* lam_re = ldp(tab, 21); const float* lam_im = ldp(tab, 22);
            const float* ssm_b_re = ldp(tab, 24); const float* ssm_b_im = ldp(tab, 25);
            for (int i = gtid; i < 2 * 32 * 17 * 64; i += NGT) {
                const int p = i & 63, d = (i >> 6) % 17, dg = i / (64 * 17);
                const float st = fast_exp(log_step[dg]);
                LPOW[i] = lam_pow(lam_re[dg * 64 + p], lam_im[dg * 64 + p], st, d);
            }
            for (int i = gtid; i < 2 * 32 * 64 * 16; i += NGT) {
                const int dgp = i >> 4, dg = dgp >> 6;
                const float st = fast_exp(log_step[dg]);
                const f32x2 lam = (f32x2){lam_re[dgp], lam_im[dgp]};
                const f32x2 z = lam * st;
                f32x2 phi;
                if (z.x * z.x + z.y * z.y < 0.25f) {
                    f32x2 acc = (f32x2){1.f, 0.f};
#pragma unroll
                    for (int n = 12; n >= 2; --n) { acc = cmul(acc, z) * (1.0f / (float)n); acc.x += 1.0f; }
                    phi = acc * st;
                } else {
                    const f32x2 L = lam_pow(lam.x, lam.y, st, 1);
                    const f32x2 num = (f32x2){L.x - 1.0f, L.y}; const float den = 1.0f / (lam.x * lam.x + lam.y * lam.y);
                    phi = (f32x2){(num.x * lam.x + num.y * lam.y) * den, (num.y * lam.x - num.x * lam.y) * den};
                }
                BBAR[i] = cmul(phi, (f32x2){ssm_b_re[i], ssm_b_im[i]});
            }
        }
        {
            const float* pool_w = ldp(tab, 15); const float* pool_scale = ldp(tab, 16);
            for (int i = gtid; i < 128 * 1024; i += NGT) { const int n = i & 1023, k0 = (i >> 10) * 4, gq = k0 >> 7, c = k0 & 127;
                const float* pw = pool_w + ((size_t)gq * 128 + c) * 128; const float* ps = pool_scale + gq * 128; const float* wo = ab_w_out + (size_t)(gq * 128) * 1024 + n;
                float a0 = 0.f, a1 = 0.f, a2 = 0.f, a3 = 0.f;
#pragma unroll 32
                for (int d = 0; d < 128; ++d) { const float wv = ps[d] * wo[(size_t)d * 1024]; a0 += pw[d] * wv; a1 += pw[128 + d] * wv; a2 += pw[256 + d] * wv; a3 += pw[384 + d] * wv; }
                u32x2 w; w.x = cvt_pk_bf16(a0, a1); w.y = cvt_pk_bf16(a2, a3);
                *(u32x2*)(WOUT0 + (size_t)n * 1024 + k0) = w; }
        }
    }
    SEAM(0);

    if (IN(1)) REP(1) { PHASE_IDS
        const float* x_prompt = ldp(tab, 0);
        const float* x_sample = ldp(tab, 1);
        const float* norm1_g = ldp(tab, 8);
        rms_mod_rows(x_prompt, x_sample - (size_t)NP * D, H, (bf16*)(ws + WS_XB), norm1_g, MODS, 0, gw, NGW, lane);
    }
    SEAM(1);

    if (IN(2)) REP(2) {
        pg8::Gemm g{H, WIN0, 1024, 1024, 1024}; pg8::Sched S; S.init(48, 8, G, bx, 0);
        pg8::EpiStore<0> E{PROJ0, 2048};
        pg8::gemm_phase(lds, wave, g, S, E);
        if (bx >= 128) {
            const float* ssm_c_re = ldp(tab, 26); const float* ssm_c_im = ldp(tab, 27);
            const int sid = (bx - 128) * NTHR + wave * 64 + lane_id();
            if (sid < 64 * 256) {
                const int gi = sid & 15, go = (sid >> 4) & 15, dg = sid >> 8;
                const float* cr = ssm_c_re + ((size_t)dg * 16 + go) * 64; const float* ci = ssm_c_im + ((size_t)dg * 16 + go) * 64;
                const f32x2* lp = LPOW + ((size_t)dg * 17 + 1) * 64; const f32x2* bb = BBAR + (size_t)dg * 64 * 16 + gi;
                float a[16];
#pragma unroll
                for (int d = 0; d < 16; ++d) a[d] = 0.f;
#pragma unroll 2
                for (int p = 0; p < 64; ++p) { f32x2 v = cmul((f32x2){cr[p], ci[p]}, bb[p * 16]); const f32x2 L = lp[p];
#pragma unroll
                    for (int d = 0; d < 16; ++d) { a[d] += v.x; v = cmul(v, L); } }
#pragma unroll
                for (int d = 0; d < 16; ++d) KTAB[(((size_t)dg * 16 + d) * 16 + go) * 16 + gi] = a[d];
            }
        }
    }
    SEAM(2);

    if (IN(3)) REP(3) { PHASE_IDS
        const float* conv_w = ldp(tab, 17);

        for (int it = gtid; it < NTOK * 128; it += NGT) {
            int r, cv;
            if (it < NTOK * 64) { const int gq = it / (NTOK * 16), rem = it - gq * (NTOK * 16); r = rem >> 4; cv = gq * 16 + (rem & 15); }
            else { const int i2 = it - NTOK * 64; r = i2 >> 6; cv = 64 + (i2 & 63); }
            int sb, T, t;
            if (r < NP) { sb = r & ~255; T = 256; t = r & 255; } else { const int rs = r - NP; sb = NP + (rs & ~2047); T = 2048; t = rs & 2047; }
            float o[8];
            if (cv < 64) {
                const int gq = cv >> 4, hw = 1 << gq; const int l0 = t - hw < 0 ? 0 : t - hw, h1 = t + hw > T ? T : t + hw;
                float a[8];
#pragma unroll
                for (int q = 0; q < 8; ++q) a[q] = 0.f;
                const bf16* pb = PROJ0 + (size_t)sb * 2048 + cv * 8;
#define POOL_WIN(HW) { u32x4 w_[2 * HW]; _Pragma("unroll") for (int k = 0; k < 2 * HW; ++k) { int tt = t - HW + k; const bool ok = tt >= l0 && tt < h1; tt = ok ? tt : t; w_[k] = *(const u32x4*)(pb + (size_t)tt * 2048); if (!ok) w_[k] = (u32x4){0u, 0u, 0u, 0u}; } \
                    _Pragma("unroll") for (int k = 0; k < 2 * HW; ++k) { float f[8]; unpack8(w_[k], f); _Pragma("unroll") for (int q = 0; q < 8; ++q) a[q] += f[q]; } }
                if (gq == 0) POOL_WIN(1) else if (gq == 1) POOL_WIN(2) else if (gq == 2) POOL_WIN(4) else POOL_WIN(8)
#undef POOL_WIN
                float sf[8]; unpack8(*(const u32x4*)(pb + (size_t)t * 2048), sf);
                const float ic = 1.0f / (float)(h1 - l0);
#pragma unroll
                for (int q = 0; q < 8; ++q) o[q] = a[q] * ic - sf[q];
                *(u32x4*)(Z + (size_t)r * D + cv * 8) = pack8(o);
            } else {
                const int ch0 = (cv - 64) * 8;
                float bg[8]; unpack8(*(const u32x4*)(PROJ0 + (size_t)r * 2048 + 512 + ch0), bg);
#pragma unroll
                for (int q = 0; q < 8; ++q) o[q] = 0.f;
#pragma unroll
                for (int j = 0; j < 3; ++j) { const int tt = t + j - 1;
                    if (tt >= 0 && tt < T) { float cg8[8], vv[8]; const bf16* pr = PROJ0 + (size_t)(sb + tt) * 2048 + ch0;
                        unpack8(*(const u32x4*)(pr + 1024), cg8); unpack8(*(const u32x4*)(pr + 1536), vv);
                        const f32x4 w0 = *(const f32x4*)(conv_w + j * 512 + ch0), w1 = *(const f32x4*)(conv_w + j * 512 + ch0 + 4);
#pragma unroll
                        for (int q = 0; q < 4; ++q) { o[q] += w0[q] * cg8[q] * vv[q]; o[q + 4] += w1[q] * cg8[q + 4] * vv[q + 4]; } } }
#pragma unroll
                for (int q = 0; q < 8; ++q) o[q] *= bg[q];
                *(u32x4*)(Z + (size_t)r * D + 512 + ch0) = pack8(o);
            }
        }
    }
    SEAM(3);

    if (IN(4)) REP(4) {
        const float* x_prompt = ldp(tab, 0);
        const float* x_sample = ldp(tab, 1);

        pg8::Gemm g{Z, WOUT0, 1024, 1024, 1024}; pg8::Sched S; S.init(48, 4, G, bx, 3);
        pg8::EpiResGateNorm E{nullptr, nullptr, X, MODS + 2 * 1024, ldp(tab, 9), MODS, 3, H, XBUF, PCNT + 0 * 48 * 64, lds + LDS_XOFF, (pg8::bf16_t*)(ws + WS_XB)};
        pg8::gemm_phase(lds, wave, g, S, E);
    }
    SEAM2(4, 6);
    if (IN(6)) REP(6) {
        pg8::Gemm g{H, W1_0, 1024, 1024, 1024}; pg8::Sched S; S.init(48, 16, G, bx, 0);
        pg8::EpiStore<1> E{HID, 4096};
        pg8::gemm_phase(lds, wave, g, S, E);
    }
    SEAM(6);
    if (IN(7)) REP(7) {
        pg8::Gemm g{HID, W2_0, 4096, 4096, 4096}; pg8::Sched S; S.init(48, 4, G, bx, 3);
        pg8::EpiResGateNorm E{nullptr, nullptr, X, MODS + 5 * 1024, ldp(tab, 8) + 1024, MODS + 5 * 6144, 0, H, XBUF + (size_t)1 * NTOK * 4, PCNT + 1 * 48 * 64, lds + LDS_XOFF, (pg8::bf16_t*)(ws + WS_XB)};
        pg8::gemm_phase(lds, wave, g, S, E);
        if (bx >= 192) {
            const float* mlp_w1 = ldp(tab, 12); const float* mlp_w2 = ldp(tab, 13); const float* cd_w_in = ldp(tab, 19); const float* cd_w_out = ldp(tab, 31); const float* glu_w = ldp(tab, 29);
            LAS float* scr = (LAS float*)(lds + wave * 16384); const int lane = lane_id();
            constexpr int J0 = 1024, J1 = J0 + 512, J2 = J1 + 128;
            for (int it = (bx - 192) * NWAVES + wave; it < J2; it += 64 * NWAVES) {
                if (it < J0) tr_item(cd_w_in, 2048, WIN1, 1024, scr, it, lane);
                else if (it < J1) tr_item(cd_w_out, 1024, WOUT1, 1024, scr, it - J0, lane);
                else tr_item(glu_w, 512, GLUT, 512, scr, it - J1, lane);
            }
            const float* ssm_c_re = ldp(tab, 26); const float* ssm_c_im = ldp(tab, 27); const float* ssm_d = ldp(tab, 28);
            const int sid = (bx - 192) * NTHR + wave * 64 + lane;
#pragma unroll 4
            for (int i = sid; i < 32 * 256 * 128; i += 64 * NTHR) {
                const int k = (i & 127) * 2, n = (i >> 7) & 255, gg = i >> 15, j = k >> 4, gi = k & 15, dir = n >> 7, p = (n & 127) >> 1, ri = n & 1;
                const int dg = dir * 32 + gg, e = dir == 0 ? 15 - j : j;
                const f32x2 L = LPOW[((size_t)dg * 17 + e) * 64 + p];
                const f32x2 v0 = cmul(L, BBAR[((size_t)dg * 64 + p) * 16 + gi]), v1 = cmul(L, BBAR[((size_t)dg * 64 + p) * 16 + gi + 1]);
                *(unsigned*)(FMAT + ((size_t)gg * 256 + n) * 512 + k) = cvt_pk_bf16(ri ? v0.y : v0.x, ri ? v1.y : v1.x);
            }
#pragma unroll 4
            for (int i = sid; i < 32 * 256 * 128; i += 64 * NTHR) {
                const int kk = (i & 127) * 2, n = (i >> 7) & 255, gg = i >> 15, t = n >> 4, go = n & 15, dir = kk >> 7, p = (kk & 127) >> 1;
                const int dg = dir * 32 + gg, e = dir == 0 ? t + 1 : 16 - t;
                const size_t ci = ((size_t)dg * 16 + go) * 64 + p;
                const f32x2 v = cmul((f32x2){ssm_c_re[ci], ssm_c_im[ci]}, LPOW[((size_t)dg * 17 + e) * 64 + p]);
                *(unsigned*)(BMAT + ((size_t)gg * 256 + n) * 512 + 256 + kk) = cvt_pk_bf16(v.x, -v.y);
            }
#pragma unroll 4
            for (int i = sid; i < 32 * 256 * 128; i += 64 * NTHR) {
                const int k = (i & 127) * 2, n = (i >> 7) & 255, gg = i >> 15, j = k >> 4, gi = k & 15, t = n >> 4, go = n & 15;
                float v0 = 0.f, v1 = 0.f;
                if (t >= j) { const float* kt = KTAB + (((size_t)(0 * 32 + gg) * 16 + (t - j)) * 16 + go) * 16 + gi; v0 += kt[0]; v1 += kt[1]; }
                if (j >= t) { const float* kt = KTAB + (((size_t)(1 * 32 + gg) * 16 + (j - t)) * 16 + go) * 16 + gi; v0 += kt[0]; v1 += kt[1]; }
                if (j == t) { const float dd = ssm_d[gg * 16 + go]; if (go == gi) v0 += dd; if (go == gi + 1) v1 += dd; }
                *(unsigned*)(BMAT + ((size_t)gg * 256 + n) * 512 + k) = cvt_pk_bf16(v0, v1);
            }
            {
                const float* cache_k = ldp(tab, 3); const float* cache_v = ldp(tab, 4);
                for (int i = sid; i < 4 * 8 * 256 * 64 / 2; i += 64 * NTHR) { const f32x2 v = *(const f32x2*)(cache_k + 2 * (size_t)i); ((unsigned*)KC)[i] = cvt_pk_bf16(v.x, v.y); }
                for (int i = sid; i < 4 * 8 * 64 * 256 / 2; i += 64 * NTHR) { const int d = i & 63, l2 = (i >> 6) & 127, bh = i >> 13;
                    const float a = cache_v[((size_t)bh * 256 + 2 * l2) * 64 + d], b = cache_v[((size_t)bh * 256 + 2 * l2 + 1) * 64 + d];
                    *(unsigned*)(VTC + ((size_t)(bh * 64 + d)) * VPP + 2 * l2) = cvt_pk_bf16(a, b); }
            }
        }
    }
    SEAM2(7, 9);
    if (IN(9)) REP(9) {
        { pg8::Gemm g{H, WIN1, 1024, 1024, 1024}; pg8::Sched S; S.init(48, 6, G, bx, 1);
          pg8::EpiProj1 E{QKV, ABUF, out + O_K};
          pg8::gemm_phase(lds, wave, g, S, E); }
        { pg8::Gemm g{WIN1 + (size_t)1024 * 1024, H, 1024, 1024, 1024}; pg8::Sched S; S.init(2, 48, G, (bx + G - 32) % G, 0);
          pg8::EpiVT E{VTP, VTS, out + O_V};
          pg8::gemm_phase(lds, wave, g, S, E); }
        if (bx >= 128) {
            const float* mlp_w1 = ldp(tab, 12); const float* mlp_w2 = ldp(tab, 13);
            LAS float* scr = (LAS float*)(lds + wave * 16384); const int lane = lane_id();
            for (int it = (bx - 128) * NWAVES + wave; it < 4096; it += 128 * NWAVES) {
                if (it < 2048) tr_item(mlp_w1 + (size_t)1024 * 4096, 4096, W1_1, 1024, scr, it, lane);
                else tr_item(mlp_w2 + (size_t)4096 * 1024, 1024, W2_1, 4096, scr, it - 2048, lane);
            }
        }
    }
    SEAM2(9, 12);

#define ATTN_QUEUE(pi, jb, jn) do { \
    const int xq_ = (int)(xb_xcc_id() & 7u); unsigned* ctr_ = QCTR + ((pi) * 8 + xq_) * 16; \
    volatile LAS unsigned* qw_ = (volatile LAS unsigned*)(lds + 131072 + 64); \
    for (;;) { \
        __syncthreads(); \
        if (threadIdx.x == 0) qw_[0] = __hip_atomic_fetch_add(ctr_, 8u, __ATOMIC_RELAXED, __HIP_MEMORY_SCOPE_AGENT); \
        __syncthreads(); \
        const int f_ = (int)qw_[0]; \
        if (f_ >= (jn)) break; \
        const int j_ = (jb) + f_ + wave; \
        if (f_ + wave < (jn)) { \
        const int id = j_ < 256 ? xq_ * 256 + j_ : 2048 + xq_ * 512 + (j_ - 256); \
        const int ll = lane_id(); \
        const int l16 = ll & 15; \
        if (id < 2048) { \
            const int bh = id >> 4, qt = id & 15, b = bh >> 3, hh = bh & 7; \
            const int tq = b * 256 + qt * 16 + l16; \
            attn_unit<false>(QKV + (size_t)tq * QP + hh * 64, QKV + (size_t)(b * 256) * QP + 512 + hh * 64, VTP + (size_t)(bh * 64) * VPP, \
                             nullptr, nullptr, (const LAS float*)nullptr, 0, 0, 0, 0, Z + (size_t)tq * D + hh * 64, ll, lds + wave * 16384); \
        } else { \
            const int i2 = id - 2048, cb = i2 & 3, r = (i2 >> 2) & 31, bh = i2 >> 7, b = bh >> 3, hh = bh & 7; \
            int r0 = r - 4; r0 = r0 < 0 ? 0 : (r0 > 24 ? 24 : r0); \
            int s0 = cb * 16 - 8; s0 = s0 < 0 ? 0 : (s0 > 32 ? 32 : s0); \
            const int tb = NP + b * 2048, tq = tb + r * 64 + cb * 16 + l16; \
            attn_unit<true>(QKV + (size_t)tq * QP + hh * 64, QKV + (size_t)(tb + r0 * 64 + s0) * QP + 512 + hh * 64, \
                            VTS + (size_t)(bh * 64) * VSP + r0 * 64 + s0, KC + (size_t)bh * 256 * 64, VTC + (size_t)bh * 64 * VPP, \
                            rpb_l + hh * 465, r, r0, s0, cb, Z + (size_t)tq * D + hh * 64, ll, lds + wave * 16384); \
        } } \
    } } while (0)
    constexpr int AQ0 = 368, AQ1 = 184, AQ2 = 768 - AQ0 - AQ1;
    unsigned* QCTR = (unsigned*)(ws + WS_BAR) + 3584;
    const LAS float* rpb_l = (const LAS float*)(lds + LDS_RPB);
    if (IN(12)) REP(12) {
        { int kf = 256; asm volatile("" : "+s"(kf)); pg8::Gemm g{ABUF, FMAT, 512, 512, kf}; pg8::Sched S; S.init(96, 1, G, bx, 2);
          pg8::EpiF E{FBUF};
          pg8::gemm_phase(lds, wave, g, S, E); }
        asm volatile("s_waitcnt vmcnt(0)" ::: "memory");
        __syncthreads();
        if (bx < 96) {
            const float* st_re = ldp(tab, 5); const float* st_im = ldp(tab, 6);
            const int gg = bx / 3, ui = bx % 3, tid = wave * 64 + lane_id();
            const int nseq = ui == 0 ? 2048 : 256;
            for (int sq = tid; sq < nseq; sq += NTHR) {
                const int p = sq & 63, dir = (sq >> 6) & 1, bb = ui == 0 ? (sq >> 7) : 16 + (ui - 1) * 2 + (sq >> 7);
            const int nch = bb < 16 ? 16 : 128, cb0 = bb < 16 ? bb * 16 : 256 + (bb - 16) * 128;
            const f32x2 L16 = LPOW[((size_t)(dir * 32 + gg) * 17 + 16) * 64 + p];
            f32x2 S = (f32x2){0.f, 0.f};
            if (bb >= 16) { const size_t si = ((size_t)((bb - 16) * 2 + dir) * 32 + gg) * 64 + p; S = (f32x2){st_re[si], st_im[si]}; }
            f32x2 fa[16], fb[16];
#define SCAN_LOAD(dst, q0) { _Pragma("unroll") for (int u = 0; u < 16; ++u) { const int c = dir == 0 ? (q0) + u : nch - 1 - (q0) - u; dst[u] = *(const f32x2*)(FBUF + ((size_t)gg * 768 + cb0 + c) * 256 + dir * 128 + p * 2); } }
#define SCAN_STEP(src_, q0) { _Pragma("unroll") for (int u = 0; u < 16; ++u) { const int c = dir == 0 ? (q0) + u : nch - 1 - (q0) - u; \
                    ((unsigned*)ABUF)[(((size_t)gg * 768 + cb0 + c) * 512 + 256 + dir * 128 + p * 2) >> 1] = cvt_pk_bf16(S.x, S.y); S = cmul(L16, S) + src_[u]; } }
            SCAN_LOAD(fa, 0);
            for (int q0 = 0; q0 < nch; q0 += 32) {
                if (q0 + 16 < nch) SCAN_LOAD(fb, q0 + 16);
                SCAN_STEP(fa, q0);
                if (q0 + 16 < nch) { if (q0 + 32 < nch) SCAN_LOAD(fa, q0 + 32); SCAN_STEP(fb, q0 + 16); }
            }
#undef SCAN_LOAD
#undef SCAN_STEP
            if (bb < 16) { const size_t oi = ((size_t)(bb * 2 + dir) * 32 + gg) * 64 + p; out[O_SRE + oi] = S.x; out[O_SIM + oi] = S.y; }
            }
            asm volatile("s_waitcnt vmcnt(0)" ::: "memory");
            __syncthreads();
        }
        { pg8::Gemm g{ABUF, BMAT, 512, 512, 512}; pg8::Sched S; S.init(96, 1, G, bx, 2);
          pg8::EpiY E{YBUF};
          pg8::gemm_phase(lds, wave, g, S, E); }
        if (G == 256) {
            if (bx >= 96) {
                ctx_block_unit(vcu, QKV, VTP, Z, lds, wave, lane_id());
                const int jq = ((bx - 96) & 7) * 20 + ((bx - 96) >> 3);
                na_block_unit(2 * jq, QKV, VTS, KC, VTC, rpb_l, Z, lds, wave, lane_id());
                na_block_unit(2 * jq + 1, QKV, VTS, KC, VTC, rpb_l, Z, lds, wave, lane_id());
            }
        } else {
            for (int bu = vcu; bu < 768; bu += G) {
                const int ln = lane_id();
                if (bu < 256) ctx_block_unit(bu, QKV, VTP, Z, lds, wave, ln);
                else na_block_unit(bu - 256, QKV, VTS, KC, VTC, rpb_l, Z, lds, wave, ln);
            }
        }
    }
    SEAM(12);
    if (IN(13)) REP(13) {
        const float* glu_b = ldp(tab, 30);

        pg8::Gemm g{YBUF, GLUT, 512, 512, 512}; pg8::Sched S; S.init(48, 2, G, bx, 0);
        pg8::EpiGLU E{YBUF, Z, glu_b};
        pg8::gemm_phase(lds, wave, g, S, E);
        if (G == 256 && bx >= 96) {
            const int jq = ((bx - 96) & 7) * 20 + ((bx - 96) >> 3);
            na_block_unit(320 + jq, QKV, VTS, KC, VTC, rpb_l, Z, lds, wave, lane_id());
            if (jq < 32) na_block_unit(480 + jq, QKV, VTS, KC, VTC, rpb_l, Z, lds, wave, lane_id());
        }
        if (G == 256 && bx < 96) ctx_block_unit(vcu, QKV, VTP, Z, lds, wave, lane_id());
    }
    SEAM(13);
    if (IN(14)) REP(14) {
        pg8::Gemm g{Z, WOUT1, 1024, 1024, 1024}; pg8::Sched S; S.init(48, 4, G, bx, 3);
        pg8::EpiResGateNorm E{nullptr, nullptr, X, MODS + 5 * 6144 + 2 * 1024, ldp(tab, 9) + 1024, MODS + 5 * 6144, 3, H, XBUF + (size_t)2 * NTOK * 4, PCNT + 2 * 48 * 64, lds + LDS_XOFF, (pg8::bf16_t*)(ws + WS_XB)};
        pg8::gemm_phase(lds, wave, g, S, E);
    }
    SEAM2(14, 16);
    if (IN(16)) REP(16) {
        pg8::Gemm g{H, W1_1, 1024, 1024, 1024}; pg8::Sched S; S.init(48, 16, G, bx, 0);
        pg8::EpiStore<1> E{HID, 4096};
        pg8::gemm_phase(lds, wave, g, S, E);
    }
    SEAM(16);
    if (IN(17)) REP(17) {
        pg8::Gemm g{HID, W2_1, 4096, 4096, 4096}; pg8::Sched S; S.init(48, 4, G, bx, 3);
        pg8::EpiResGateNorm E{nullptr, nullptr, X, MODS + 5 * 6144 + 5 * 1024, ldp(tab, 32), MODS, 0, nullptr, XBUF + (size_t)3 * NTOK * 4, PCNT + 3 * 48 * 64, lds + LDS_XOFF, (pg8::bf16_t*)(ws + WS_XB)};
        pg8::gemm_phase(lds, wave, g, S, E);
    }
#undef IN
#undef SEAM
#undef SEAM2
}

extern "C" void kernel_launch(void* const* d_in, const int* in_sizes, int n_in, void* d_out, int out_size, void* d_ws, size_t ws_size, hipStream_t stream) {
    static int grid = 0;
    if (grid == 0) {
        if (n_in != 33 || ws_size < WS_END) { fprintf(stderr, "kernel_launch: unexpected n_in %d / ws_size %zu\n", n_in, ws_size); grid = -1; return; }
        int dev = 0, cus = 0, per_cu = 0;
        hipGetDevice(&dev);
        hipDeviceGetAttribute(&cus, hipDeviceAttributeMultiprocessorCount, dev);
        if (hipFuncSetAttribute((const void*)fwd_megakernel, hipFuncAttributeMaxDynamicSharedMemorySize, LDS_BYTES) != hipSuccess) { fprintf(stderr, "kernel_launch: hipFuncSetAttribute failed\n"); grid = -1; return; }
        if (hipOccupancyMaxActiveBlocksPerMultiprocessor(&per_cu, (const void*)fwd_megakernel, NTHR, LDS_BYTES) != hipSuccess || per_cu < 1) { fprintf(stderr, "kernel_launch: occupancy query gave %d\n", per_cu); per_cu = 1; (void)hipGetLastError(); }
        grid = cus;
        fprintf(stderr, "kernel_launch: cus %d per_cu %d grid %d\n", cus, per_cu, grid);
    }
    if (grid < 0) return;
    Args a{};
    for (int i = 0; i < 33; ++i) a.in[i] = (const float*)d_in[i];
    a.out = (float*)d_out; a.ws = (unsigned char*)d_ws;
#if MK_N_LAUNCHES == 1
    if (hipMemsetAsync((char*)d_ws + WS_BAR, 0, 65536, stream) != hipSuccess) { fprintf(stderr, "kernel_launch: memset of barrier words failed\n"); return; }
    a.ph_lo = 0; a.ph_hi = NPHASES;
    void* kargs[] = {&a};
    hipError_t e = hipLaunchCooperativeKernel((const void*)fwd_megakernel, dim3(grid), dim3(NTHR), kargs, LDS_BYTES, stream);
    if (e != hipSuccess) fprintf(stderr, "cooperative launch failed: %s (grid %d)\n", hipGetErrorString(e), grid);
#else
    for (int ph = 0; ph < NPHASES; ++ph) {
        a.ph_lo = ph; a.ph_hi = ph + 1;
        hipLaunchKernelGGL(fwd_megakernel, dim3(grid), dim3(NTHR), LDS_BYTES, stream, a);
    }
#endif
}
```
